# Optimizing an MI355X kernel written in HIP

```python
import math
import numpy as np
import jax
import jax.numpy as jnp
from jax import lax

D_MODEL = 1024
BATCH = 32
SEQ = 256
DEPTH = 2
DEC_BATCH = 4
DEC_SEQ = 4096
PAST_LEN = 256

GRID_W = 64
BLOCK = 128
A_HEADS = 4
A_DQK = 32
A_DV = 64
B_HEADS = 8
B_KV_HEADS = 2
B_GROUP = B_HEADS // B_KV_HEADS
B_DH = 64
WINDOW = 128
C_HEADS = 4
C_Q_RANK = 256
C_KV_RANK = 128
C_NOPE = 64
C_ROPE = 32
C_DV = 64
MIX_WIDTH = A_HEADS * A_DV + B_HEADS * B_DH + C_HEADS * C_DV
IN_WIDTHS = (A_HEADS * 2 * A_DQK, A_HEADS * 2 * A_DQK, A_HEADS * A_DV,
             B_HEADS * B_DH, B_KV_HEADS * B_DH, B_KV_HEADS * B_DH,
             C_Q_RANK, C_KV_RANK, C_ROPE)
IN_WIDTH = sum(IN_WIDTHS)
D_FF = 2816
N_MOD = 9
ROPE_BASE = 10000.0
LN_EPS = 1e-5
RMS_EPS = 1e-6
DN_ALPHA = (2 * DEPTH) ** 0.25
DN_BETA = (8 * DEPTH) ** -0.25
FFN_RES = 0.5

kernel_name = 'hybrid_diff_prefix_trunk_step'


def _layernorm(x, g, b):
    xf = x.astype(jnp.float32)
    mu = jnp.mean(xf, axis=-1, keepdims=True)
    var = jnp.mean(jnp.square(xf - mu), axis=-1, keepdims=True)
    y = (xf - mu) * lax.rsqrt(var + LN_EPS)
    return (y * g.astype(jnp.float32) + b.astype(jnp.float32)).astype(x.dtype)


def _rmsnorm(x, g):
    xf = x.astype(jnp.float32)
    y = xf * lax.rsqrt(jnp.mean(jnp.square(xf), axis=-1, keepdims=True) + RMS_EPS)
    return (y * g.astype(jnp.float32)).astype(x.dtype)


def _modulation(cond, w, b):
    return (jax.nn.silu(cond) @ w + b).reshape(cond.shape[0], N_MOD, D_MODEL)


def _modulate(x, shift, scale):
    return x * (1.0 + scale[:, None, :]) + shift[:, None, :]


def _residual_post_norm(x, f, gate, weight, g, b):
    return _layernorm(DN_ALPHA * x + weight * gate[:, None, :] * f, g, b)


def _ffn_half(x, mod, slot, w1, w3, w2, g, b):
    h = _modulate(x, mod[:, 3 * slot], mod[:, 3 * slot + 1])
    f = (jax.nn.silu(h @ w1) * (h @ w3)) @ w2
    return _residual_post_norm(x, f, mod[:, 3 * slot + 2], FFN_RES, g, b)


def _axial_rope_tables(rows, dim):
    row = jnp.repeat(jnp.arange(rows, dtype=jnp.float32), GRID_W)
    col = jnp.tile(jnp.arange(GRID_W, dtype=jnp.float32), rows)
    a = dim // 2
    inv = jnp.power(ROPE_BASE, -jnp.arange(0, a, 2, dtype=jnp.float32) / a)
    ar = row[:, None] * inv[None, :]
    ac = col[:, None] * inv[None, :]
    ang = jnp.concatenate([ar, ar, ac, ac], axis=-1)
    return jnp.cos(ang), jnp.sin(ang)


def _rope(x, cos, sin):
    dim = x.shape[-1]
    a = dim // 2
    q = a // 2
    xr, xc = x[..., :a], x[..., a:]
    rot = jnp.concatenate([-xr[..., q:], xr[..., :q], -xc[..., q:], xc[..., :q]], axis=-1)
    return x * cos[:, None, :].astype(x.dtype) + rot * sin[:, None, :].astype(x.dtype)


def _sweep_query_blocks(fn, *qs):
    b, n = qs[0].shape[:2]
    nb = n // BLOCK
    blocks = tuple(jnp.swapaxes(q.reshape(b, nb, BLOCK, *q.shape[2:]), 0, 1) for q in qs)
    out = lax.map(lambda qb: fn(*qb), blocks)
    out = jnp.swapaxes(out, 0, 1)
    return out.reshape(b, n, *out.shape[3:])


def _sink_softmax(s, sink):
    m = jnp.maximum(jnp.max(s, axis=-1, keepdims=True), sink)
    e = jnp.exp(s - m)
    return e / (jnp.sum(e, axis=-1, keepdims=True) + jnp.exp(sink - m))


def _diff_lambda(lam_params, lam_init):
    lp = lam_params.astype(jnp.float32)
    return jnp.exp(jnp.sum(lp[0] * lp[1])) - jnp.exp(jnp.sum(lp[2] * lp[3])) + lam_init


def _diff_attn(q, k, v, lam, subln_g, lam_init):
    scale = A_DQK ** -0.5

    def one_block(qb):
        s = jnp.einsum('bqhjd,bkhjd->bhjqk', qb, k).astype(jnp.float32) * scale
        p = jax.nn.softmax(s, axis=-1)
        w = p[:, :, 0] - lam * p[:, :, 1]
        return jnp.einsum('bhqk,bkhd->bqhd', w.astype(v.dtype), v)

    o = _sweep_query_blocks(one_block, q)
    return _rmsnorm(o, subln_g) * (1.0 - lam_init)


def _sink_attn_dense(q, k, v, sink):
    scale = B_DH ** -0.5
    sk = sink.astype(jnp.float32).reshape(1, B_KV_HEADS, B_GROUP, 1, 1)

    def one_block(qb):
        s = jnp.einsum('bqhgd,bkhd->bhgqk', qb, k).astype(jnp.float32) * scale
        p = _sink_softmax(s, sk)
        return jnp.einsum('bhgqk,bkhd->bqhgd', p.astype(v.dtype), v)

    return _sweep_query_blocks(one_block, q)


def _band_blocks(t):
    b, n = t.shape[:2]
    nb = n // BLOCK
    tb = t.reshape(b, nb, BLOCK, *t.shape[2:])
    tp = jnp.pad(tb, ((0, 0), (1, 1)) + ((0, 0),) * (tb.ndim - 2))
    return jnp.concatenate([tp[:, :-2], tp[:, 1:-1], tp[:, 2:]], axis=2)


def _sink_attn_banded(q, k, v, k_ctx, v_ctx, sink):
    b, n = q.shape[:2]
    nb = n // BLOCK
    n_ctx = k_ctx.shape[1]
    scale = B_DH ** -0.5
    qb = q.reshape(b, nb, BLOCK, B_KV_HEADS, B_GROUP, B_DH)
    kw = _band_blocks(k)
    vw = _band_blocks(v)
    s_loc = jnp.einsum('bnqhgd,bnkhd->bnhgqk', qb, kw).astype(jnp.float32) * scale
    s_ctx = jnp.einsum('bnqhgd,bkhd->bnhgqk', qb, k_ctx).astype(jnp.float32) * scale
    blk = jnp.arange(nb)[:, None, None]
    qi = jnp.arange(BLOCK)[None, :, None]
    kj = jnp.arange(3 * BLOCK)[None, None, :]
    kpos = (blk - 1) * BLOCK + kj
    qpos = blk * BLOCK + qi
    valid = (jnp.abs(kpos - qpos) <= WINDOW) & (kpos >= 0) & (kpos < n)
    s_loc = jnp.where(valid[None, :, None, None], s_loc, -jnp.inf)
    sk = sink.astype(jnp.float32).reshape(1, 1, B_KV_HEADS, B_GROUP, 1, 1)
    p = _sink_softmax(jnp.concatenate([s_ctx, s_loc], axis=-1), sk)
    p_ctx = p[..., :n_ctx].astype(v.dtype)
    p_loc = p[..., n_ctx:].astype(v.dtype)
    o = (jnp.einsum('bnhgqk,bkhd->bnqhgd', p_ctx, v_ctx)
         + jnp.einsum('bnhgqk,bnkhd->bnqhgd', p_loc, vw))
    return o.reshape(b, n, B_KV_HEADS, B_GROUP, B_DH)


def _mla(q_nope, q_pe, c_kv, k_pe, w_kv_up):
    w_uk = w_kv_up[..., :C_NOPE]
    w_uv = w_kv_up[..., C_NOPE:]
    q_lat = jnp.einsum('bqhd,chd->bqhc', q_nope, w_uk)
    scale = (C_NOPE + C_ROPE) ** -0.5

    def one_block(ql, qp):
        s = (jnp.einsum('bqhc,bkc->bhqk', ql, c_kv)
             + jnp.einsum('bqhr,bkr->bhqk', qp, k_pe)).astype(jnp.float32) * scale
        p = jax.nn.softmax(s, axis=-1)
        return jnp.einsum('bhqk,bkc->bqhc', p.astype(c_kv.dtype), c_kv)

    o_lat = _sweep_query_blocks(one_block, q_lat, q_pe)
    return jnp.einsum('bqhc,chd->bqhd', o_lat, w_uv)


def _project(h, w_in, q_norm_g, w_q_up, kv_norm_g, ropes):
    b, n, _ = h.shape
    offs = np.cumsum(IN_WIDTHS)[:-1].tolist()
    a_q, a_k, a_v, b_q, b_k, b_v, c_qd, c_kvd, c_kpe = jnp.split(h @ w_in, offs, axis=-1)
    a_q = a_q.reshape(b, n, 2 * A_HEADS, A_DQK)
    a_k = a_k.reshape(b, n, 2 * A_HEADS, A_DQK)
    a_v = a_v.reshape(b, n, A_HEADS, A_DV)
    b_q = b_q.reshape(b, n, B_HEADS, B_DH)
    b_k = b_k.reshape(b, n, B_KV_HEADS, B_DH)
    b_v = b_v.reshape(b, n, B_KV_HEADS, B_DH)
    c_q = (_rmsnorm(c_qd, q_norm_g) @ w_q_up).reshape(b, n, C_HEADS, C_NOPE + C_ROPE)
    c_qn, c_qp = c_q[..., :C_NOPE], c_q[..., C_NOPE:]
    c_kv = _rmsnorm(c_kvd, kv_norm_g)
    c_kpe = c_kpe[:, :, None, :]
    if ropes is not None:
        (ca, sa), (cb, sb), (cc, sc) = ropes
        a_q = _rope(a_q, ca, sa)
        a_k = _rope(a_k, ca, sa)
        b_q = _rope(b_q, cb, sb)
        b_k = _rope(b_k, cb, sb)
        c_qp = _rope(c_qp, cc, sc)
        c_kpe = _rope(c_kpe, cc, sc)
    return (a_q.reshape(b, n, A_HEADS, 2, A_DQK), a_k.reshape(b, n, A_HEADS, 2, A_DQK), a_v,
            b_q.reshape(b, n, B_KV_HEADS, B_GROUP, B_DH), b_k, b_v,
            c_qn, c_qp, c_kv, c_kpe[:, :, 0])


def _context_state(t):
    a_q, a_k, a_v, b_q, b_k, b_v, c_qn, c_qp, c_kv, c_kpe = t
    b, n = a_k.shape[:2]
    return (a_k.reshape(b, n, A_HEADS, 2 * A_DQK), a_v, b_k, b_v, c_kv, c_kpe)


def _mix(t, ctx, lam, lam_init, subln_g, sink, w_kv_up, w_o):
    a_q, a_k, a_v, b_q, b_k, b_v, c_qn, c_qp, c_kv, c_kpe = t
    b, n = a_q.shape[:2]
    if ctx is None:
        o_a = _diff_attn(a_q, a_k, a_v, lam, subln_g, lam_init)
        o_b = _sink_attn_dense(b_q, b_k, b_v, sink)
        o_c = _mla(c_qn, c_qp, c_kv, c_kpe, w_kv_up)
    else:
        ctx_ak, ctx_av, ctx_bk, ctx_bv, ctx_ckv, ctx_ckpe = ctx
        n_ctx = ctx_ak.shape[1]
        ak_all = jnp.concatenate([ctx_ak.reshape(b, n_ctx, A_HEADS, 2, A_DQK), a_k], axis=1)
        av_all = jnp.concatenate([ctx_av, a_v], axis=1)
        o_a = _diff_attn(a_q, ak_all, av_all, lam, subln_g, lam_init)
        o_b = _sink_attn_banded(b_q, b_k, b_v, ctx_bk, ctx_bv, sink)
        o_c = _mla(c_qn, c_qp, jnp.concatenate([ctx_ckv, c_kv], axis=1),
                   jnp.concatenate([ctx_ckpe, c_kpe], axis=1), w_kv_up)
    o = jnp.concatenate([o_a.reshape(b, n, -1), o_b.reshape(b, n, -1), o_c.reshape(b, n, -1)], axis=-1)
    return o @ w_o


def setup_inputs(seed: int = 0) -> dict:
    key = jax.random.key(seed)
    ks = jax.random.split(key, 32)

    def nrm(k, shape, s):
        return jax.random.normal(k, shape, jnp.float32) * s

    return {
        'x_prompt': nrm(ks[0], (BATCH, SEQ, D_MODEL), 1.0),
        'x_sample': nrm(ks[1], (DEC_BATCH, DEC_SEQ, D_MODEL), 1.0),
        'cache_a_k': nrm(ks[2], (DEC_BATCH, DEPTH, PAST_LEN, A_HEADS, 2 * A_DQK), 1.0),
        'cache_a_v': nrm(ks[3], (DEC_BATCH, DEPTH, PAST_LEN, A_HEADS, A_DV), 1.0),
        'cache_b_k': nrm(ks[4], (DEC_BATCH, DEPTH, PAST_LEN, B_KV_HEADS, B_DH), 1.0),
        'cache_b_v': nrm(ks[5], (DEC_BATCH, DEPTH, PAST_LEN, B_KV_HEADS, B_DH), 1.0),
        'cache_c_kv': nrm(ks[6], (DEC_BATCH, DEPTH, PAST_LEN, C_KV_RANK), 1.0),
        'cache_c_kpe': nrm(ks[7], (DEC_BATCH, DEPTH, PAST_LEN, C_ROPE), 1.0),
        'c': nrm(ks[8], (DEC_BATCH, D_MODEL), 1.0),
        'c_ctx': nrm(ks[9], (D_MODEL,), 1.0),
        'w_mod': nrm(ks[10], (DEPTH, D_MODEL, N_MOD * D_MODEL), D_MODEL ** -0.5),
        'b_mod': nrm(ks[11], (DEPTH, N_MOD * D_MODEL), 0.02),
        'ln_g': 1.0 + nrm(ks[12], (DEPTH, 3, D_MODEL), 0.02),
        'ln_b': nrm(ks[13], (DEPTH, 3, D_MODEL), 0.02),
        'ffn_w1': nrm(ks[14], (DEPTH, 2, D_MODEL, D_FF), D_MODEL ** -0.5),
        'ffn_w3': nrm(ks[15], (DEPTH, 2, D_MODEL, D_FF), D_MODEL ** -0.5),
        'ffn_w2': nrm(ks[16], (DEPTH, 2, D_FF, D_MODEL), D_FF ** -0.5 * DN_BETA),
        'w_in': nrm(ks[17], (DEPTH, D_MODEL, IN_WIDTH), D_MODEL ** -0.5),
        'w_o': nrm(ks[18], (DEPTH, MIX_WIDTH, D_MODEL), MIX_WIDTH ** -0.5 * DN_BETA),
        'a_lambda': nrm(ks[19], (DEPTH, 4, A_DQK), 0.1),
        'a_subln_g': 1.0 + nrm(ks[20], (DEPTH, A_DV), 0.02),
        'b_sink': nrm(ks[21], (DEPTH, B_HEADS), 0.5),
        'c_q_norm_g': 1.0 + nrm(ks[22], (DEPTH, C_Q_RANK), 0.02),
        'c_w_q_up': nrm(ks[23], (DEPTH, C_Q_RANK, C_HEADS * (C_NOPE + C_ROPE)), C_Q_RANK ** -0.5),
        'c_kv_norm_g': 1.0 + nrm(ks[24], (DEPTH, C_KV_RANK), 0.02),
        'c_w_kv_up': nrm(ks[25], (DEPTH, C_KV_RANK, C_HEADS, C_NOPE + C_DV), C_KV_RANK ** -0.5),
    }


def reference(x_prompt, x_sample, cache_a_k, cache_a_v, cache_b_k, cache_b_v, cache_c_kv, cache_c_kpe,
              c, c_ctx, w_mod, b_mod, ln_g, ln_b, ffn_w1, ffn_w3, ffn_w2, w_in, w_o,
              a_lambda, a_subln_g, b_sink, c_q_norm_g, c_w_q_up, c_kv_norm_g, c_w_kv_up):
    n_lat = x_sample.shape[1]
    rows = n_lat // GRID_W
    ropes = (_axial_rope_tables(rows, A_DQK), _axial_rope_tables(rows, B_DH), _axial_rope_tables(rows, C_ROPE))
    xp = x_prompt
    xs = x_sample
    st_ak, st_av, st_bk, st_bv, st_ckv, st_ckpe = [], [], [], [], [], []
    for l in range(DEPTH):
        lam_init = 0.8 - 0.6 * math.exp(-0.3 * l)
        lam = _diff_lambda(a_lambda[l], lam_init)
        mod_p = _modulation(c_ctx[None, :], w_mod[l], b_mod[l])
        mod_s = _modulation(c, w_mod[l], b_mod[l])
        proj_w = (w_in[l], c_q_norm_g[l], c_w_q_up[l], c_kv_norm_g[l])
        mix_w = (lam, lam_init, a_subln_g[l], b_sink[l], c_w_kv_up[l], w_o[l])
        ffn1 = (ffn_w1[l, 0], ffn_w3[l, 0], ffn_w2[l, 0], ln_g[l, 0], ln_b[l, 0])
        ffn2 = (ffn_w1[l, 1], ffn_w3[l, 1], ffn_w2[l, 1], ln_g[l, 2], ln_b[l, 2])

        xp = _ffn_half(xp, mod_p, 0, *ffn1)
        tp = _project(_modulate(xp, mod_p[:, 3], mod_p[:, 4]), *proj_w, None)
        xp = _residual_post_norm(xp, _mix(tp, None, *mix_w), mod_p[:, 5], 1.0, ln_g[l, 1], ln_b[l, 1])
        s_ak, s_av, s_bk, s_bv, s_ckv, s_ckpe = _context_state(tp)
        st_ak.append(s_ak)
        st_av.append(s_av)
        st_bk.append(s_bk)
        st_bv.append(s_bv)
        st_ckv.append(s_ckv)
        st_ckpe.append(s_ckpe)
        xp = _ffn_half(xp, mod_p, 2, *ffn2)

        xs = _ffn_half(xs, mod_s, 0, *ffn1)
        ctx = (cache_a_k[:, l], cache_a_v[:, l], cache_b_k[:, l], cache_b_v[:, l],
               cache_c_kv[:, l], cache_c_kpe[:, l])
        ts = _project(_modulate(xs, mod_s[:, 3], mod_s[:, 4]), *proj_w, ropes)
        xs = _residual_post_norm(xs, _mix(ts, ctx, *mix_w), mod_s[:, 5], 1.0, ln_g[l, 1], ln_b[l, 1])
        xs = _ffn_half(xs, mod_s, 2, *ffn2)

    new_a_k = jnp.stack(st_ak, axis=1)
    new_a_v = jnp.stack(st_av, axis=1)
    new_b_k = jnp.stack(st_bk, axis=1)
    new_b_v = jnp.stack(st_bv, axis=1)
    new_c_kv = jnp.stack(st_ckv, axis=1)
    new_c_kpe = jnp.stack(st_ckpe, axis=1)
    return (xp, xs, new_a_k, new_a_v, new_b_k, new_b_v, new_c_kv, new_c_kpe)
```

```cpp
#include <hip/hip_runtime.h>
#include <hip/hip_cooperative_groups.h>
#include <cstdio>
#include <cstdint>
namespace cg = cooperative_groups;
namespace pg8 {
#define PG8_LAS __attribute__((address_space(3)))
typedef unsigned short bf16_t;
typedef short bf16x8 __attribute__((ext_vector_type(8)));
typedef float f32x4 __attribute__((ext_vector_type(4)));
typedef unsigned u32x4 __attribute__((ext_vector_type(4)));
constexpr int BM = 256, BK = 64, HALF = 128, HTB = HALF * BK * 2  , STAGE_BYTES = 8 * HTB, NXCD = 8, WGM = 4;

__host__ __device__ __forceinline__ int lds_byte(int r, int c) { const int st = (r >> 4) * 2 + (c >> 5), rr = r & 15, cc = c & 31, ob = rr * 64 + cc * 2; return st * 1024 + (ob ^ (((ob >> 9) & 1) << 5)); }
__host__ __device__ __forceinline__ void stage_rc(int b, int& R, int& C) { const int st = b / 1024, sb = b % 1024, swz = sb ^ (((sb >> 9) & 1) << 5); R = (st >> 1) * 16 + swz / 64; C = (st & 1) * 32 + (swz % 64) / 2; }
__host__ __device__ __forceinline__ int perm32(int rho) { const int n = rho >> 4, i = rho & 15; return 8 * (i >> 2) + 4 * n + (i & 3); }

struct Unit { int pm, pn; };
struct Gemm { const bf16_t* A; const bf16_t* Bt; int M, N, K; };

struct StaticOrder {
    int nM, nN, nwg, G, c;
    __host__ __device__ void init(int M, int N, int G_, int c_) { nM = M / BM; nN = N / BM; nwg = nM * nN; G = G_; c = c_; }
    __host__ __device__ bool next(int i, Unit& u) const {
        const long L = (long)i * G + c; if (L >= nwg) return false;
        int wgid = (int)L; { const int q = nwg / NXCD, r = nwg % NXCD, xcd = wgid % NXCD, off = wgid / NXCD; wgid = (xcd < r ? xcd * (q + 1) : r * (q + 1) + (xcd - r) * q) + off; }
        const int nig = WGM * nN, gid = wgid / nig, fm = gid * WGM, gsz = (nM - fm) < WGM ? (nM - fm) : WGM;
        u.pm = fm + ((wgid % nig) % gsz); u.pn = (wgid % nig) / gsz; return true;
    }
    __device__ __forceinline__ void a_ready(const Unit&) const {}
    __device__ __forceinline__ void done(const Unit&) const {}
};
typedef float f32x2_t __attribute__((ext_vector_type(2)));
typedef __bf16 bf16x2_t __attribute__((ext_vector_type(2)));
__device__ __forceinline__ unsigned cvt_pk_bf16(float lo, float hi) { f32x2_t v = {lo, hi}; bf16x2_t b = __builtin_convertvector(v, bf16x2_t); return __builtin_bit_cast(unsigned, b); }
__device__ __forceinline__ float silu_f(float a) { return a * __builtin_amdgcn_rcpf(1.0f + __builtin_amdgcn_exp2f(-1.4426950408889634f * a)); }
constexpr float DN_ALPHA_F = 1.4142135623730951f;
__device__ __forceinline__ int req_of_tile(int pm) { return pm < 32 ? 0 : 1 + ((pm - 32) >> 4); }

struct EpiSwiGLU {
    static constexpr bool PERM = true, AFTER_DRAIN = false;
    bf16_t* G; int ldg;
    __device__ __forceinline__ void operator()(const f32x4 (&acc)[2][2][4][2], const Unit& u, int wr, int wc, int fr, int fq) const {
        const int row0 = u.pm * BM + wr * 64 + fr; const int col0 = u.pn * HALF + wc * 32 + 8 * fq;
#pragma unroll
        for (int ai = 0; ai < 2; ++ai)
#pragma unroll
            for (int m = 0; m < 4; ++m) {
                bf16_t* rowp = G + (size_t)(row0 + ai * HALF + m * 16) * ldg + col0;
                const f32x4 a0 = acc[ai][0][m][0], a1 = acc[ai][0][m][1], b0 = acc[ai][1][m][0], b1 = acc[ai][1][m][1];
                u32x4 w;
                w.x = cvt_pk_bf16(silu_f(a0[0]) * b0[0], silu_f(a0[1]) * b0[1]); w.y = cvt_pk_bf16(silu_f(a0[2]) * b0[2], silu_f(a0[3]) * b0[3]);
                w.z = cvt_pk_bf16(silu_f(a1[0]) * b1[0], silu_f(a1[1]) * b1[1]); w.w = cvt_pk_bf16(silu_f(a1[2]) * b1[2], silu_f(a1[3]) * b1[3]);
                *(u32x4*)rowp = w;
            }
    }
};
struct RParams { const float* in[26]; float* out; unsigned char* ws; int ph_lo, ph_hi; };
constexpr size_t RWS_LNG = 544 * 1024, RWS_STATS = 576 * 1024, RWS_LNB = 800 * 1024;
struct EpiResid {
    static constexpr bool PERM = false, AFTER_DRAIN = false;
    const __attribute__((address_space(4))) RParams* kp; int goff, lnoff; float wgt;
    __device__ __forceinline__ void operator()(const f32x4 (&acc)[2][2][4][2], const Unit& u, int wr, int wc, int fr, int fq) const {
        const int row0 = u.pm * BM + wr * 64 + fr; const int col0 = u.pn * BM + wc * 32 + 4 * fq;
        float* X = kp->out; const unsigned char* ws = kp->ws;
        const float* gp = (const float*)ws + goff + (size_t)req_of_tile(u.pm) * 9216 + col0;
        const f32x2_t* stats = (const f32x2_t*)(ws + RWS_STATS); const float* lng = (const float*)(ws + RWS_LNG) + lnoff; const float* lnb = (const float*)(ws + RWS_LNB) + lnoff;
        const float* R = (lnoff == 0) ? (u.pm < 32 ? kp->in[0] : kp->in[1] - (size_t)8192 * 1024) : (const float*)X;
        f32x4 gv[2][2], g4[2][2], b4[2][2];
#pragma unroll
        for (int bj = 0; bj < 2; ++bj)
#pragma unroll
            for (int n = 0; n < 2; ++n) { gv[bj][n] = *(const f32x4*)(gp + bj * HALF + n * 16) * wgt; g4[bj][n] = *(const f32x4*)(lng + col0 + bj * HALF + n * 16) * DN_ALPHA_F; b4[bj][n] = *(const f32x4*)(lnb + col0 + bj * HALF + n * 16) * DN_ALPHA_F; }
#pragma unroll
        for (int ai = 0; ai < 2; ++ai)
#pragma unroll
            for (int m = 0; m < 4; ++m) {
                const int row = row0 + ai * HALF + m * 16; const f32x2_t st = stats[row];
                float* rowp = X + (size_t)row * 1024 + col0;
#pragma unroll
                for (int bj = 0; bj < 2; ++bj)
#pragma unroll
                    for (int n = 0; n < 2; ++n) { f32x4* xp = (f32x4*)(rowp + bj * HALF + n * 16); const f32x4 xv = *(const f32x4*)(R + (size_t)row * 1024 + col0 + bj * HALF + n * 16);
                        *xp = ((xv - st.x) * st.y) * g4[bj][n] + b4[bj][n] + gv[bj][n] * acc[ai][bj][m][n]; }
                if (m == 3) asm volatile("" ::: "memory");
            }
    }
};
struct EpiStoreBf16 {
    static constexpr bool PERM = true, AFTER_DRAIN = false;
    bf16_t* O; int ldc;
    __device__ __forceinline__ void operator()(const f32x4 (&acc)[2][2][4][2], const Unit& u, int wr, int wc, int fr, int fq) const {
        const int row0 = u.pm * BM + wr * 64 + fr; const int col0 = u.pn * BM + wc * 32 + 8 * fq;
#pragma unroll
        for (int ai = 0; ai < 2; ++ai)
#pragma unroll
            for (int m = 0; m < 4; ++m) { bf16_t* rowp = O + (size_t)(row0 + ai * HALF + m * 16) * ldc + col0;
#pragma unroll
                for (int bj = 0; bj < 2; ++bj) { const f32x4 v0 = acc[ai][bj][m][0], v1 = acc[ai][bj][m][1];
                    u32x4 w; w.x = cvt_pk_bf16(v0[0], v0[1]); w.y = cvt_pk_bf16(v0[2], v0[3]); w.z = cvt_pk_bf16(v1[0], v1[1]); w.w = cvt_pk_bf16(v1[2], v1[3]);
                    *(u32x4*)(rowp + bj * HALF) = w; } }
    }
};
struct EpiQup {
    static constexpr bool PERM = true, AFTER_DRAIN = false;
    bf16_t* O; const f32x2_t* tab32;
    __device__ __forceinline__ void operator()(const f32x4 (&acc)[2][2][4][2], const Unit& u, int wr, int wc, int fr, int fq) const {
        const int row0 = u.pm * BM + wr * 64 + fr; const int col0 = u.pn * BM + wc * 32 + 8 * fq;
        const bool rope = (u.pn == 2) && (u.pm >= 32);
#pragma unroll
        for (int ai = 0; ai < 2; ++ai)
#pragma unroll
            for (int m = 0; m < 4; ++m) { const int row = row0 + ai * HALF + m * 16; bf16_t* rowp = O + (size_t)row * 768 + col0;
#pragma unroll
                for (int bj = 0; bj < 2; ++bj) { f32x4 v0 = acc[ai][bj][m][0], v1 = acc[ai][bj][m][1];
                    if (bj == 0 && rope) {
                        const int t = (row - 8192) & 4095; const int pos = (fq < 2) ? (t >> 6) : (t & 63); const int f0 = (4 * fq) & 7;
                        const f32x2_t* tp = tab32 + pos * 8 + f0;
                        const f32x2_t c0 = tp[0], c1 = tp[1], c2 = tp[2], c3 = tp[3];
                        f32x4 r0, r1;
                        r0[0] = v0[0] * c0.x - v0[1] * c0.y; r0[1] = v0[1] * c0.x + v0[0] * c0.y;
                        r0[2] = v0[2] * c1.x - v0[3] * c1.y; r0[3] = v0[3] * c1.x + v0[2] * c1.y;
                        r1[0] = v1[0] * c2.x - v1[1] * c2.y; r1[1] = v1[1] * c2.x + v1[0] * c2.y;
                        r1[2] = v1[2] * c3.x - v1[3] * c3.y; r1[3] = v1[3] * c3.x + v1[2] * c3.y;
                        v0 = r0; v1 = r1;
                    }
                    u32x4 w; w.x = cvt_pk_bf16(v0[0], v0[1]); w.y = cvt_pk_bf16(v0[2], v0[3]); w.z = cvt_pk_bf16(v1[0], v1[1]); w.w = cvt_pk_bf16(v1[2], v1[3]);
                    *(u32x4*)(rowp + bj * HALF) = w; }
                asm volatile("" ::: "memory"); }
    }
};

template <class Epi, class Sched, bool ALIGN_EPI = false, bool SP2 = false>
__device__ __forceinline__ void gemm_phase(PG8_LAS unsigned char* lds, const Gemm g, const Sched& S, const Epi& E) {
    int tid_ = threadIdx.x; asm volatile("" : "+v"(tid_));
    const int tid = tid_, wid = __builtin_amdgcn_readfirstlane(tid >> 6), lane = tid & 63, wr = wid >> 2, wc = wid & 3, fr = lane & 15, fq = lane >> 4;
    const int K = g.K, nt = K / BK;
    unsigned voffA[2], voffB[2];
#pragma unroll
    for (int i = 0; i < 2; ++i) { int R, C; stage_rc(tid * 16 + i * 8192, R, C); const int Rb = Epi::PERM ? ((R & ~31) + perm32(R & 31)) : R;
        voffA[i] = (unsigned)(R * K + C) * 2u; voffB[i] = (unsigned)(Rb * K + C) * 2u; }
    const size_t kstep = (size_t)(BK * 2);
    const size_t hstep = (size_t)HALF * K * 2;
    const size_t tstep = 2 * hstep;
    const unsigned ldsw = (unsigned)wid * 1024u;
    const int aoff = lds_byte(wr * 64 + fr, fq * 8), boff = lds_byte(wc * 32 + fr, fq * 8);
#define PG8_SA(b, h) (((b) * 2 + (h)) * HTB)
#define PG8_SB(b, h) ((4 + (b) * 2 + (h)) * HTB)
#define PG8_STAGE(bufoff, gbase, voff) do { _Pragma("unroll") for (int _i = 0; _i < 2; ++_i) \
        __builtin_amdgcn_global_load_lds((const unsigned*)((const char*)(gbase) + (voff)[_i]), (PG8_LAS unsigned*)(lds + (bufoff) + ldsw + _i * 8192), 16, 0, 0); } while (0)
#define PG8_LDA(dst, b, h) do { _Pragma("unroll") for (int m = 0; m < 4; ++m) _Pragma("unroll") for (int k = 0; k < 2; ++k) dst[m][k] = *(const PG8_LAS bf16x8*)(lds + PG8_SA(b, h) + aoff + m * 2048 + k * 1024); } while (0)
#define PG8_LDB(dst, b, h) do { _Pragma("unroll") for (int n = 0; n < 2; ++n) _Pragma("unroll") for (int k = 0; k < 2; ++k) dst[n][k] = *(const PG8_LAS bf16x8*)(lds + PG8_SB(b, h) + boff + n * 2048 + k * 1024); } while (0)
#define PG8_MMA(ai, bj, At, Bt) do { __builtin_amdgcn_s_setprio(1); _Pragma("unroll") for (int m = 0; m < 4; ++m) _Pragma("unroll") for (int n = 0; n < 2; ++n) _Pragma("unroll") for (int k = 0; k < 2; ++k) \
        acc[ai][bj][m][n] = __builtin_amdgcn_mfma_f32_16x16x32_bf16(Bt[n][k], At[m][k], acc[ai][bj][m][n], 0, 0, 0); __builtin_amdgcn_s_setprio(0); } while (0)
#define PG8_WAIT_V(n) asm volatile("s_waitcnt vmcnt(" #n ")" ::: "memory")
#define PG8_WAIT_L(n) asm volatile("s_waitcnt lgkmcnt(" #n ")" ::: "memory")
#define PG8_BAR __builtin_amdgcn_s_barrier()
#define PG8_SCHED __builtin_amdgcn_sched_barrier(0)
    Unit cur, nxt; int ui = 0;
    if (!S.next(0, cur)) return;
    f32x4 acc[2][2][4][2];
#pragma unroll
    for (int a = 0; a < 2; ++a)
#pragma unroll
        for (int b = 0; b < 2; ++b)
#pragma unroll
            for (int m = 0; m < 4; ++m)
#pragma unroll
                for (int n = 0; n < 2; ++n) acc[a][b][m][n] = (f32x4){0.f, 0.f, 0.f, 0.f};
    bf16x8 At[4][2], B0[2][2], B1[2][2];
    const char* cA = (const char*)g.A + (size_t)cur.pm * tstep; const char* cB = (const char*)g.Bt + (size_t)cur.pn * tstep;
    S.a_ready(cur);
    if constexpr (SP2) {
        PG8_STAGE(PG8_SB(0, 0), cB, voffB); PG8_STAGE(PG8_SB(0, 1), cB + hstep, voffB); PG8_STAGE(PG8_SA(0, 0), cA, voffA); PG8_STAGE(PG8_SA(0, 1), cA + hstep, voffA);
        if (wr == 1) PG8_BAR;
        PG8_WAIT_V(2); PG8_BAR;
        PG8_STAGE(PG8_SB(1, 0), cB + kstep, voffB); PG8_STAGE(PG8_SA(1, 0), cA + kstep, voffA); PG8_STAGE(PG8_SB(1, 1), cB + hstep + kstep, voffB);
        PG8_WAIT_V(6); PG8_BAR;
    } else {
        PG8_STAGE(PG8_SB(0, 0), cB, voffB); PG8_STAGE(PG8_SA(0, 0), cA, voffA); PG8_STAGE(PG8_SB(0, 1), cB + hstep, voffB); PG8_STAGE(PG8_SA(0, 1), cA + hstep, voffA);
        if (wr == 1) PG8_BAR;
        PG8_WAIT_V(4); PG8_BAR;
        PG8_STAGE(PG8_SB(1, 0), cB + kstep, voffB); PG8_STAGE(PG8_SA(1, 0), cA + kstep, voffA); PG8_STAGE(PG8_SB(1, 1), cB + hstep + kstep, voffB);
        PG8_WAIT_V(6); PG8_BAR;
    }
    for (;;) {
        const bool has_next = S.next(ui + 1, nxt);
        const char* nA = has_next ? (const char*)g.A + (size_t)nxt.pm * tstep : cA; const char* nB = has_next ? (const char*)g.Bt + (size_t)nxt.pn * tstep : cB;
        for (int t = 0; t < nt; t += 2) {
            const bool last = (t == nt - 2);
            const char* a1 = cA + (size_t)(t + 1) * kstep;
            const char* a2 = last ? nA : cA + (size_t)(t + 2) * kstep; const char* b2 = last ? nB : cB + (size_t)(t + 2) * kstep;
            const char* a3 = a2 + kstep; const char* b3 = b2 + kstep;
            if (last && has_next) S.a_ready(nxt);
            if constexpr (SP2) {
            PG8_LDB(B0, 0, 0); PG8_LDB(B1, 0, 1); PG8_SCHED; PG8_LDA(At, 0, 0); PG8_STAGE(PG8_SA(1, 1), a1 + hstep, voffA);
            PG8_WAIT_V(8); PG8_WAIT_L(0); PG8_BAR; PG8_MMA(0, 0, At, B0); PG8_MMA(0, 1, At, B1); PG8_BAR; PG8_SCHED;
            PG8_LDA(At, 0, 1); PG8_STAGE(PG8_SB(0, 0), b2, voffB); PG8_STAGE(PG8_SB(0, 1), b2 + hstep, voffB); PG8_STAGE(PG8_SA(0, 0), a2, voffA);
            PG8_WAIT_V(8); PG8_WAIT_L(0); PG8_BAR; PG8_MMA(1, 0, At, B0); PG8_MMA(1, 1, At, B1); PG8_BAR; PG8_SCHED;
            PG8_LDB(B0, 1, 0); PG8_LDB(B1, 1, 1); PG8_SCHED; PG8_LDA(At, 1, 0); PG8_STAGE(PG8_SA(0, 1), a2 + hstep, voffA);
            PG8_WAIT_V(8); PG8_WAIT_L(0); PG8_BAR; PG8_MMA(0, 0, At, B0); PG8_MMA(0, 1, At, B1); PG8_BAR; PG8_SCHED;
            PG8_LDA(At, 1, 1); PG8_STAGE(PG8_SB(1, 0), b3, voffB); PG8_STAGE(PG8_SB(1, 1), b3 + hstep, voffB); PG8_STAGE(PG8_SA(1, 0), a3, voffA);
            PG8_WAIT_V(8); PG8_WAIT_L(0); PG8_BAR; PG8_MMA(1, 0, At, B0); PG8_MMA(1, 1, At, B1); PG8_BAR; PG8_SCHED;
            } else {
            PG8_LDB(B0, 0, 0); PG8_SCHED; PG8_LDA(At, 0, 0); PG8_STAGE(PG8_SA(1, 1), a1 + hstep, voffA);
            PG8_WAIT_L(8); PG8_BAR; PG8_WAIT_L(0); PG8_MMA(0, 0, At, B0); PG8_BAR; PG8_SCHED;
            PG8_LDB(B1, 0, 1); PG8_STAGE(PG8_SB(0, 0), b2, voffB);
            PG8_BAR; PG8_WAIT_L(0); PG8_MMA(0, 1, At, B1); PG8_BAR;
            PG8_LDA(At, 0, 1); PG8_STAGE(PG8_SA(0, 0), a2, voffA);
            PG8_BAR; PG8_WAIT_L(0); PG8_MMA(1, 0, At, B0); PG8_BAR; PG8_SCHED;
            PG8_STAGE(PG8_SB(0, 1), b2 + hstep, voffB);
            PG8_WAIT_V(6); PG8_BAR; PG8_MMA(1, 1, At, B1); PG8_BAR;
            PG8_LDB(B0, 1, 0); PG8_SCHED; PG8_LDA(At, 1, 0); PG8_STAGE(PG8_SA(0, 1), a2 + hstep, voffA);
            PG8_WAIT_L(8); PG8_BAR; PG8_WAIT_L(0); PG8_MMA(0, 0, At, B0); PG8_BAR; PG8_SCHED;
            PG8_LDB(B1, 1, 1); PG8_STAGE(PG8_SB(1, 0), b3, voffB);
            PG8_BAR; PG8_WAIT_L(0); PG8_MMA(0, 1, At, B1); PG8_BAR;
            PG8_LDA(At, 1, 1); PG8_STAGE(PG8_SA(1, 0), a3, voffA);
            PG8_BAR; PG8_WAIT_L(0); PG8_MMA(1, 0, At, B0); PG8_BAR; PG8_SCHED;
            PG8_STAGE(PG8_SB(1, 1), b3 + hstep, voffB);
            PG8_WAIT_V(6); PG8_BAR; PG8_MMA(1, 1, At, B1); PG8_BAR;
            }
        }
        if constexpr (ALIGN_EPI) { if (wr == 0) PG8_BAR; }
        if constexpr (!Epi::AFTER_DRAIN) { E(acc, cur, wr, wc, fr, fq); S.done(cur); }
        if (!has_next) break;
#pragma unroll
        for (int a = 0; a < 2; ++a)
#pragma unroll
            for (int b = 0; b < 2; ++b)
#pragma unroll
                for (int m = 0; m < 4; ++m)
#pragma unroll
                    for (int n = 0; n < 2; ++n) acc[a][b][m][n] = (f32x4){0.f, 0.f, 0.f, 0.f};
        cur = nxt; cA = nA; cB = nB; ++ui;
        if constexpr (ALIGN_EPI) { if (wr == 1) PG8_BAR; }
    }
    PG8_WAIT_V(0);
    if constexpr (!ALIGN_EPI) { if (wr == 0) PG8_BAR; }
    PG8_BAR;
    if constexpr (Epi::AFTER_DRAIN) { E.fused(acc, cur, wr, wc, fr, fq, lds, wid, lane); S.done(cur); }
#undef PG8_SA
#undef PG8_SB
#undef PG8_STAGE
#undef PG8_LDA
#undef PG8_LDB
#undef PG8_MMA
#undef PG8_WAIT_V
#undef PG8_WAIT_L
#undef PG8_BAR
#undef PG8_SCHED
}
}

#define LAS __attribute__((address_space(3)))
typedef unsigned short bf16_t;
typedef short bf16x8 __attribute__((ext_vector_type(8)));
typedef short s16x4 __attribute__((ext_vector_type(4)));
typedef short v4i16_t __attribute__((ext_vector_type(4)));
typedef float f32x4 __attribute__((ext_vector_type(4)));
typedef float f32x2 __attribute__((ext_vector_type(2)));
typedef float f32x16 __attribute__((ext_vector_type(16)));
typedef unsigned u32x4 __attribute__((ext_vector_type(4)));
typedef unsigned u32x2 __attribute__((ext_vector_type(2)));

constexpr int NTOK = 24576, NPTOK = 8192;
constexpr int DM = 1024, DFF = 2816, INW = 1952, INWP = 2048, MIXK = 1280, QCW = 768;
constexpr int KVROWS = 8192 + 4 * 4352;
constexpr float LOG2E = 1.4426950408889634f;
constexpr float QSC_A = 0.17677669529663687f * LOG2E;
constexpr float QSC_B = 0.125f * LOG2E;
constexpr float QSC_C = 0.10206207261596575f * LOG2E;

constexpr size_t WS_MOD = 0;
constexpr size_t MOD_BYTES = 2 * 5 * 9216 * 4;
constexpr size_t WS_BAR = 384 * 1024;
constexpr size_t ZERO_BYTES = WS_BAR + 3456 * 4;
constexpr size_t WS_TAB32 = 512 * 1024;
constexpr size_t WS_TAB64 = WS_TAB32 + 8192;
constexpr size_t WS_LNG = 544 * 1024, WS_LNB = 800 * 1024;
constexpr size_t WS_STATS = 576 * 1024;
constexpr size_t WS_W13 = 1048576;
constexpr size_t W13_ONE = (size_t)5632 * 1024 * 2;
constexpr size_t WS_W2 = WS_W13 + 4 * W13_ONE;
constexpr size_t W2_ONE = (size_t)1024 * 2816 * 2;
constexpr size_t WS_WIN = WS_W2 + 4 * W2_ONE;
constexpr size_t WIN_ONE = (size_t)2048 * 1024 * 2;
constexpr size_t WS_WO = WS_WIN + 2 * WIN_ONE;
constexpr size_t WO_ONE = (size_t)1024 * 1280 * 2;
constexpr size_t WS_WQ = WS_WO + 2 * WO_ONE;
constexpr size_t WQ_ONE = (size_t)768 * 256 * 2;
constexpr size_t WS_H = WS_WQ + 2 * WQ_ONE;
constexpr size_t WS_QA = WS_H, WS_QB = WS_QA + (size_t)NTOK * 256 * 2, WS_CQN = WS_QB + (size_t)NTOK * 512 * 2;
constexpr size_t WS_G = WS_H + (size_t)NTOK * 1024 * 2;
constexpr size_t WS_PROJ = WS_G, WS_QC = WS_G, WS_OMIX = WS_G + (size_t)NTOK * 768 * 2;
constexpr size_t WS_KA = WS_G + (size_t)NTOK * 2816 * 2;
constexpr size_t WS_VA = WS_KA + (size_t)KVROWS * 256 * 2;
constexpr size_t WS_KB = WS_VA + (size_t)KVROWS * 256 * 2;
constexpr size_t WS_VB = WS_KB + (size_t)KVROWS * 128 * 2;
constexpr size_t WS_KC = WS_VB + (size_t)KVROWS * 128 * 2;
constexpr size_t WS_END = WS_KC + (size_t)KVROWS * 160 * 2;
static_assert(WS_CQN + (size_t)NTOK * 256 * 2 == WS_G, "Q overlay fills H exactly");
static_assert(WS_OMIX + (size_t)NTOK * 1280 * 2 <= WS_KA, "omix inside G region");

constexpr size_t OUT_Y = 0;
constexpr size_t OUT_AK = 25165824, OUT_AV = 29360128, OUT_BK = 33554432, OUT_BV = 35651584, OUT_CKV = 37748736, OUT_CKPE = 39845888;

constexpr int LDS_BYTES = 131072 + 1024;

struct Params { const float* in[26]; float* out; unsigned char* ws; int ph_lo, ph_hi; };
static_assert(sizeof(Params) == sizeof(pg8::RParams) && WS_LNG == pg8::RWS_LNG && WS_LNB == pg8::RWS_LNB && WS_STATS == pg8::RWS_STATS, "epilogue's view of the frame");
typedef const __attribute__((address_space(4))) Params* KPtr;

__device__ __forceinline__ int TID() { int t = threadIdx.x; asm volatile("" : "+v"(t)); return t; }
__device__ __forceinline__ int BID() { int t = blockIdx.x; asm volatile("" : "+s"(t)); return t; }
__device__ __forceinline__ int NBLK() { int t = gridDim.x; asm volatile("" : "+s"(t)); return t; }
__device__ __forceinline__ float bf2f(bf16_t b) { return __uint_as_float((unsigned)b << 16); }
__device__ __forceinline__ bf16_t f2bf(float f) { return (bf16_t)(pg8::cvt_pk_bf16(f, 0.f) & 0xffffu); }
__device__ __forceinline__ float wave_sum(float v) {
#pragma unroll
    for (int o = 1; o < 64; o <<= 1) v += __shfl_xor(v, o);
    return v;
}
__device__ __forceinline__ int rope_perm32(int d) { const int e = (d >> 3) & 1, p = (d & 7) + ((d & 16) >> 1); return 2 * p + e; }
__device__ __forceinline__ int rope_unperm32(int rho) { const int p = rho >> 1, e = rho & 1; return ((p & 8) << 1) + (p & 7) + 8 * e; }

__device__ __forceinline__ void transpose_item(const float* W, int N, bf16_t* WT, int ldk, int k0, int n0, int drow0, LAS float* scr, int lane) {
    float tv[32];
#pragma unroll
    for (int i = 0; i < 32; ++i) tv[i] = __builtin_nontemporal_load(&W[(size_t)(k0 + 2 * i + (lane >> 5)) * N + n0 + (lane & 31)]);
#pragma unroll
    for (int i = 0; i < 32; ++i) scr[(2 * i + (lane >> 5)) * 33 + (lane & 31)] = tv[i];
    asm volatile("s_waitcnt lgkmcnt(0)" ::: "memory");
    const int c = lane & 7;
#pragma unroll
    for (int j = 0; j < 4; ++j) { const int n = (lane >> 3) + 8 * j; const LAS float* s = scr + (8 * c) * 33 + n;
        u32x4 o; o.x = pg8::cvt_pk_bf16(s[0 * 33], s[1 * 33]); o.y = pg8::cvt_pk_bf16(s[2 * 33], s[3 * 33]); o.z = pg8::cvt_pk_bf16(s[4 * 33], s[5 * 33]); o.w = pg8::cvt_pk_bf16(s[6 * 33], s[7 * 33]);
        __builtin_nontemporal_store(o, (u32x4*)(WT + (size_t)(drow0 + n) * ldk + k0 + 8 * c)); }
    asm volatile("s_waitcnt lgkmcnt(0)" ::: "memory");
}

__device__ __forceinline__ void phase_prep(KPtr p, LAS unsigned char* lds) {
    const int tid = TID(), lane = tid & 63, wave = tid >> 6, bid = BID(), nblk = NBLK();
    const int gw = bid * 8 + wave, NGW = nblk * 8;
    const int gt = bid * 512 + tid, NGT = nblk * 512;
    unsigned char* ws = p->ws;
    {
        float* mod = (float*)(ws + WS_MOD);
        const float* cctx = p->in[9]; const float* cc4 = p->in[8];
        for (int it = gw; it < 2 * 32 * 36; it += NGW) {
            const int l = it / (32 * 36), r = it % (32 * 36), kc = r / 36, cc = r % 36;
            const int col = cc * 256 + lane * 4;
            const float* W = p->in[10] + ((size_t)l * 1024 + kc * 32) * 9216 + col;
            f32x4 a0 = {0.f, 0.f, 0.f, 0.f}, a1 = a0, a2 = a0, a3 = a0, a4 = a0;
#pragma unroll 8
            for (int k = 0; k < 32; ++k) {
                const f32x4 w = __builtin_nontemporal_load((const f32x4*)(W + (size_t)k * 9216));
                const int kk = kc * 32 + k;
                const float c0 = cctx[kk], c1 = cc4[kk], c2 = cc4[1024 + kk], c3 = cc4[2048 + kk], c4 = cc4[3072 + kk];
                a0 += w * (c0 / (1.f + __expf(-c0))); a1 += w * (c1 / (1.f + __expf(-c1))); a2 += w * (c2 / (1.f + __expf(-c2)));
                a3 += w * (c3 / (1.f + __expf(-c3))); a4 += w * (c4 / (1.f + __expf(-c4)));
            }
            if (kc == 0) { const f32x4 bv = *(const f32x4*)(p->in[11] + (size_t)l * 9216 + col); a0 += bv; a1 += bv; a2 += bv; a3 += bv; a4 += bv; }
            float* m0 = mod + (size_t)(l * 5) * 9216 + col;
#pragma unroll
            for (int e = 0; e < 4; ++e) { atomicAdd(m0 + e, a0[e]); atomicAdd(m0 + 9216 + e, a1[e]); atomicAdd(m0 + 2 * 9216 + e, a2[e]); atomicAdd(m0 + 3 * 9216 + e, a3[e]); atomicAdd(m0 + 4 * 9216 + e, a4[e]); }
        }
    }
    {
        LAS float* scr = (LAS float*)(lds + wave * 8704);
        constexpr int I13 = 16 * 88, I2 = 44 * 32, IIN = 16 * 61, IO = 12 * 32;
        constexpr int T13 = 8 * I13, T2 = 4 * I2, TIN = 2 * IIN, TO = 2 * IO;
        for (int it = gw; it < T13 + T2 + TIN + TO; it += NGW) {
            int r = it;
            if (r < T13) { const int mtx = r / I13, i = r % I13, lh = mtx >> 1, s = mtx & 1; const int kb = i / 88, nb = i % 88, n0 = nb * 32;
                transpose_item(p->in[s ? 15 : 14] + (size_t)lh * 1024 * 2816, 2816, (bf16_t*)(ws + WS_W13 + lh * W13_ONE), 1024, kb * 64, n0, (n0 >> 7) * 256 + s * 128 + (n0 & 127), scr, lane); continue; }
            r -= T13;
            if (r < T2) { const int lh = r / I2, i = r % I2; const int kb = i / 32, nb = i % 32;
                transpose_item(p->in[16] + (size_t)lh * 2816 * 1024, 1024, (bf16_t*)(ws + WS_W2 + lh * W2_ONE), 2816, kb * 64, nb * 32, nb * 32, scr, lane); continue; }
            r -= T2;
            if (r < TIN) { const int l = r / IIN, i = r % IIN; const int kb = i / 61, nb = i % 61;
                transpose_item(p->in[17] + (size_t)l * 1024 * 1952, 1952, (bf16_t*)(ws + WS_WIN + l * WIN_ONE), 1024, kb * 64, nb * 32, nb * 32, scr, lane); continue; }
            r -= TIN;
            { const int l = r / IO, i = r % IO; const int kb = i / 32, nb = i % 32;
                transpose_item(p->in[18] + (size_t)l * 1024 * 1024, 1024, (bf16_t*)(ws + WS_WO + l * WO_ONE), 1280, kb * 64, nb * 32, nb * 32, scr, lane); }
        }
    }
    for (int i = gt; i < 2 * 96 * 1024 / 8; i += NGT) { const int l = i / (96 * 128), r = i % (96 * 128);
        *(u32x4*)(ws + WS_WIN + l * WIN_ONE + (size_t)1952 * 2048 + (size_t)r * 16) = (u32x4){0u, 0u, 0u, 0u}; }
    for (int i = gt; i < 2 * 512 * 1024; i += NGT) {
        const int l = i >> 19, kk = (i >> 10) & 511, n = i & 1023, h = kk >> 7, c = kk & 127;
        const float* uv = p->in[25] + ((size_t)(l * 128 + c) * 4 + h) * 128 + 64;
        const float* wo = p->in[18] + ((size_t)l * 1024 + 768 + 64 * h) * 1024 + n;
        float s = 0.f;
#pragma unroll 16
        for (int d = 0; d < 64; ++d) s += uv[d] * wo[(size_t)d * 1024];
        ((bf16_t*)(ws + WS_WO + l * WO_ONE))[(size_t)n * 1280 + 768 + kk] = f2bf(s);
    }
    for (int i = gt; i < 2 * 256 * 768; i += NGT) {
        const int l = i / (256 * 768), r = i % (256 * 768), k = r / 768, n = r % 768;
        const float* qu = p->in[23] + ((size_t)l * 256 + k) * 384;
        float s = 0.f;
        if (n < 512) { const int h = n >> 7, c = n & 127; const float* uk = p->in[25] + ((size_t)(l * 128 + c) * 4 + h) * 128;
#pragma unroll 4
            for (int d = 0; d < 64; d += 4) { const f32x4 a = *(const f32x4*)(uk + d), b = *(const f32x4*)(qu + 96 * h + d); s += (a[0] * b[0] + a[1] * b[1]) + (a[2] * b[2] + a[3] * b[3]); } }
        else if (n < 640) { const int h = (n - 512) >> 5, rho = (n - 512) & 31; s = qu[96 * h + 64 + rope_unperm32(rho)]; }
        ((bf16_t*)(ws + WS_WQ + l * WQ_ONE))[(size_t)n * 256 + k] = f2bf(s * QSC_C);
    }
    for (int i = gt; i < 7 * 1024; i += NGT) { ((float*)(ws + WS_LNG))[i] = i < 1024 ? 1.0f : p->in[12][i - 1024]; ((float*)(ws + WS_LNB))[i] = i < 1024 ? 0.0f : p->in[13][i - 1024]; }
    for (int i = gt; i < 64 * 8 + 64 * 16; i += NGT) {
        if (i < 512) { const int pos = i >> 3, f = i & 7; const float inv = exp2f(-(float)(2 * f) / 16.0f * 13.287712379549449f); const float a = (float)pos * inv;
            ((f32x2*)(ws + WS_TAB32))[i] = (f32x2){cosf(a), sinf(a)}; }
        else { const int j = i - 512, pos = j >> 4, f = j & 15; const float inv = exp2f(-(float)(2 * f) / 32.0f * 13.287712379549449f); const float a = (float)pos * inv;
            ((f32x2*)(ws + WS_TAB64))[j] = (f32x2){cosf(a), sinf(a)}; }
    }
}

template <int MODE>
__device__ __forceinline__ void rows_load(KPtr p, int row, int lane, f32x4 (&v)[4]) {
    const float* src;
    if (MODE == 0) src = (row < NPTOK ? p->in[0] + (size_t)row * DM : p->in[1] + (size_t)(row - NPTOK) * DM) + lane * 4;
    else src = p->out + OUT_Y + (size_t)row * DM + lane * 4;
#pragma unroll
    for (int j = 0; j < 4; ++j) v[j] = __builtin_nontemporal_load((const f32x4*)(src + 256 * j));
}
template <int MODE>
__device__ __forceinline__ void rows_finish(KPtr p, int row, int lane, f32x4 (&v)[4], const float* lng, const float* lnb, const float* shift, const float* scale) {
    const int req = row < NPTOK ? 0 : 1 + ((row - NPTOK) >> 12);
    float* xr = p->out + OUT_Y + (size_t)row * DM + lane * 4; f32x2* stats = (f32x2*)(p->ws + WS_STATS);
    if (MODE == 0) {
        if (lane == 0) stats[row] = (f32x2){0.f, 1.f};
    } else {
        float s = 0.f;
#pragma unroll
        for (int j = 0; j < 4; ++j) s += (v[j].x + v[j].y) + (v[j].z + v[j].w);
        const float mean = wave_sum(s) * (1.f / DM); float s2 = 0.f;
#pragma unroll
        for (int j = 0; j < 4; ++j) { v[j] = v[j] - mean; s2 += (v[j].x * v[j].x + v[j].y * v[j].y) + (v[j].z * v[j].z + v[j].w * v[j].w); }
        const float rstd = 1.f / sqrtf(wave_sum(s2) * (1.f / DM) + 1e-5f);
        if (MODE == 1 && lane == 0) stats[row] = (f32x2){mean, rstd};
#pragma unroll
        for (int j = 0; j < 4; ++j) { const f32x4 g = *(const f32x4*)(lng + lane * 4 + 256 * j), b = *(const f32x4*)(lnb + lane * 4 + 256 * j);
            v[j] = v[j] * rstd * g + b; if (MODE == 2) __builtin_nontemporal_store(v[j], (f32x4*)(xr + 256 * j)); }
    }
    if (MODE != 2) {
        const float* sh = shift + (size_t)req * 9216 + lane * 4; const float* sc = scale + (size_t)req * 9216 + lane * 4;
        bf16_t* hr = (bf16_t*)(p->ws + WS_H) + (size_t)row * DM + lane * 4;
#pragma unroll
        for (int j = 0; j < 4; ++j) { const f32x4 a = *(const f32x4*)(sc + 256 * j), b = *(const f32x4*)(sh + 256 * j); const f32x4 h = v[j] * (a + 1.0f) + b;
            u32x2 w; w.x = pg8::cvt_pk_bf16(h[0], h[1]); w.y = pg8::cvt_pk_bf16(h[2], h[3]); *(u32x2*)(hr + 256 * j) = w; }
    }
}
template <int MODE>
__device__ __forceinline__ void phase_rows(KPtr p, const float* lng, const float* lnb, const float* shift, const float* scale) {
    const int tid = TID(), lane = tid & 63, wave = tid >> 6;
    const int gw = BID() * 8 + wave, NGW = NBLK() * 8;
    for (int row0 = gw; row0 < NTOK; row0 += 4 * NGW) {
        const int row1 = row0 + NGW, row2 = row0 + 2 * NGW, row3 = row0 + 3 * NGW;
        const bool ok1 = row1 < NTOK, ok2 = row2 < NTOK, ok3 = row3 < NTOK;
        f32x4 va[4], vb[4], vc[4], vd[4];
        rows_load<MODE>(p, row0, lane, va);
        if (ok1) rows_load<MODE>(p, row1, lane, vb);
        if (ok2) rows_load<MODE>(p, row2, lane, vc);
        if (ok3) rows_load<MODE>(p, row3, lane, vd);
        rows_finish<MODE>(p, row0, lane, va, lng, lnb, shift, scale);
        if (ok1) rows_finish<MODE>(p, row1, lane, vb, lng, lnb, shift, scale);
        if (ok2) rows_finish<MODE>(p, row2, lane, vc, lng, lnb, shift, scale);
        if (ok3) rows_finish<MODE>(p, row3, lane, vd, lng, lnb, shift, scale);
    }
}

__device__ __forceinline__ float rope32_val(const bf16_t* seg, int d, const f32x2* tab32, int prow, int pcol) {
    const float v = bf2f(seg[d]), pv = bf2f(seg[d ^ 8]);
    const f32x2 cs = tab32[((d < 16) ? prow : pcol) * 8 + (d & 7)];
    return (d & 8) ? (v * cs.x + pv * cs.y) : (v * cs.x - pv * cs.y);
}
__device__ __forceinline__ float rope64_val(const bf16_t* seg, int d, const f32x2* tab64, int prow, int pcol) {
    const float v = bf2f(seg[d]), pv = bf2f(seg[d ^ 16]);
    const f32x2 cs = tab64[((d < 32) ? prow : pcol) * 16 + (d & 15)];
    return (d & 16) ? (v * cs.x + pv * cs.y) : (v * cs.x - pv * cs.y);
}
__device__ __forceinline__ void pp_unpack8(u32x4 w, float (&f)[8]) {
    f[0] = __uint_as_float(w.x << 16); f[1] = __uint_as_float(w.x & 0xffff0000u); f[2] = __uint_as_float(w.y << 16); f[3] = __uint_as_float(w.y & 0xffff0000u);
    f[4] = __uint_as_float(w.z << 16); f[5] = __uint_as_float(w.z & 0xffff0000u); f[6] = __uint_as_float(w.w << 16); f[7] = __uint_as_float(w.w & 0xffff0000u); }
__device__ __forceinline__ u32x4 pp_pack8(const float (&f)[8], float sc) { u32x4 w; w.x = pg8::cvt_pk_bf16(f[0] * sc, f[1] * sc); w.y = pg8::cvt_pk_bf16(f[2] * sc, f[3] * sc); w.z = pg8::cvt_pk_bf16(f[4] * sc, f[5] * sc); w.w = pg8::cvt_pk_bf16(f[6] * sc, f[7] * sc); return w; }
__device__ __forceinline__ void pp_store8f(float* o, const float (&f)[8]) { __builtin_nontemporal_store((f32x4){f[0], f[1], f[2], f[3]}, (f32x4*)o); __builtin_nontemporal_store((f32x4){f[4], f[5], f[6], f[7]}, (f32x4*)(o + 4)); }
__device__ __forceinline__ void pp_rope8(float (&v)[8], const float (&pv)[8], int second, const f32x2* cs) {
#pragma unroll
    for (int e = 0; e < 8; ++e) { const f32x2 c = cs[e]; v[e] = second ? (v[e] * c.x + pv[e] * c.y) : (v[e] * c.x - pv[e] * c.y); } }
__device__ __forceinline__ void phase_postproj(KPtr p, int l) {
    const int tid = TID(), lane = tid & 63, wave = tid >> 6;
    const int gw = BID() * 8 + wave, NGW = NBLK() * 8;
    unsigned char* ws = p->ws;
    const bf16_t* proj = (const bf16_t*)(ws + WS_PROJ);
    bf16_t *Qa = (bf16_t*)(ws + WS_QA), *Qb = (bf16_t*)(ws + WS_QB), *cqn = (bf16_t*)(ws + WS_CQN);
    bf16_t *Ka = (bf16_t*)(ws + WS_KA), *Va = (bf16_t*)(ws + WS_VA), *Kb = (bf16_t*)(ws + WS_KB), *Vb = (bf16_t*)(ws + WS_VB), *Kc = (bf16_t*)(ws + WS_KC);
    const f32x2* tab32 = (const f32x2*)(ws + WS_TAB32); const f32x2* tab64 = (const f32x2*)(ws + WS_TAB64);
    const float* gq = p->in[22] + l * 256; const float* gkv = p->in[24] + l * 128;
    for (int row = gw; row < NTOK + 1024; row += NGW) {
        if (row >= NTOK) {
            const int cr = row - NTOK, b = cr >> 8, j = cr & 255; const size_t kv = (size_t)8192 + b * 4352 + j; const size_t ci = (size_t)(b * 2 + l) * 256 + j;
#pragma unroll
            for (int i = 0; i < 4; ++i) { const int c = 64 * i + lane; Ka[kv * 256 + c] = f2bf(__builtin_nontemporal_load(&p->in[2][ci * 256 + c])); Va[kv * 256 + c] = f2bf(__builtin_nontemporal_load(&p->in[3][ci * 256 + c])); }
#pragma unroll
            for (int i = 0; i < 2; ++i) { const int c = 64 * i + lane; Kb[kv * 128 + c] = f2bf(__builtin_nontemporal_load(&p->in[4][ci * 128 + c])); Vb[kv * 128 + c] = f2bf(__builtin_nontemporal_load(&p->in[5][ci * 128 + c])); Kc[kv * 160 + c] = f2bf(__builtin_nontemporal_load(&p->in[6][ci * 128 + c])); }
            if (lane < 32) Kc[kv * 160 + 128 + rope_perm32(lane)] = f2bf(__builtin_nontemporal_load(&p->in[7][ci * 32 + lane]));
            continue;
        }
        const bool lat = row >= NPTOK;
        const int t = (row - NPTOK) & 4095, prow = t >> 6, pcol = t & 63, bidx = (row - NPTOK) >> 12;
        const size_t kv = lat ? (size_t)8192 + bidx * 4352 + 256 + t : (size_t)row;
        const size_t orow = lat ? 0 : (size_t)((row >> 8) * 2 + l) * 256 + (row & 255);
        const bf16_t* pr = proj + (size_t)row * INWP;
        float* out = p->out;
        {
            const int c = lane & 31, src = 8 * lane, dch = c & 3; float v[8]; pp_unpack8(*(const u32x4*)(pr + src), v);
            if (lat) { float pv[8]; pp_unpack8(*(const u32x4*)(pr + (src ^ 8)), pv); pp_rope8(v, pv, dch & 1, tab32 + ((dch < 2) ? prow : pcol) * 8); }
            if (lane < 32) { *(u32x4*)(Qa + (size_t)row * 256 + 8 * c) = pp_pack8(v, QSC_A); }
            else { *(u32x4*)(Ka + kv * 256 + 8 * c) = pp_pack8(v, 1.0f); if (!lat) pp_store8f(out + OUT_AK + orow * 256 + 8 * c, v); }
        }
        {
            if (lane < 32) { const int c = lane; float v[8]; pp_unpack8(*(const u32x4*)(pr + 512 + 8 * c), v);
                *(u32x4*)(Va + kv * 256 + 8 * c) = pp_pack8(v, 1.0f); if (!lat) pp_store8f(out + OUT_AV + orow * 256 + 8 * c, v); }
            else { const int c = lane - 32, src = 768 + 8 * c, dch = c & 7; float v[8]; pp_unpack8(*(const u32x4*)(pr + src), v);
                if (lat) { float pv[8]; pp_unpack8(*(const u32x4*)(pr + (src ^ 16)), pv); pp_rope8(v, pv, (dch >> 1) & 1, tab64 + ((dch < 4) ? prow : pcol) * 16 + 8 * (dch & 1)); }
                *(u32x4*)(Qb + (size_t)row * 512 + 8 * c) = pp_pack8(v, QSC_B); }
        }
        {
            if (lane < 48) { const bool isq = lane < 32; const int c = isq ? 32 + lane : lane - 32, src = (isq ? 768 : 1280) + 8 * c, dch = c & 7; float v[8]; pp_unpack8(*(const u32x4*)(pr + src), v);
                if (lat) { float pv[8]; pp_unpack8(*(const u32x4*)(pr + (src ^ 16)), pv); pp_rope8(v, pv, (dch >> 1) & 1, tab64 + ((dch < 4) ? prow : pcol) * 16 + 8 * (dch & 1)); }
                if (isq) *(u32x4*)(Qb + (size_t)row * 512 + 8 * c) = pp_pack8(v, QSC_B);
                else { *(u32x4*)(Kb + kv * 128 + 8 * c) = pp_pack8(v, 1.0f); if (!lat) pp_store8f(out + OUT_BK + orow * 128 + 8 * c, v); } }
            else { const int c = lane - 48; float v[8]; pp_unpack8(*(const u32x4*)(pr + 1408 + 8 * c), v);
                *(u32x4*)(Vb + kv * 128 + 8 * c) = pp_pack8(v, 1.0f); if (!lat) pp_store8f(out + OUT_BV + orow * 128 + 8 * c, v); }
        }
        {
            const int c = lane < 32 ? lane : (lane < 48 ? lane - 32 : lane - 48);
            const int src = (lane < 32 ? 1536 : (lane < 48 ? 1792 : 1920)) + 8 * c;
            float v[8];
            if (lane < 52) pp_unpack8(*(const u32x4*)(pr + src), v); else {
#pragma unroll
                for (int e = 0; e < 8; ++e) v[e] = 0.f; }
            float ss = 0.f;
#pragma unroll
            for (int e = 0; e < 8; ++e) ss += v[e] * v[e];
            const float ssq = wave_sum(lane < 32 ? ss : 0.f), sskv = wave_sum((lane >= 32 && lane < 48) ? ss : 0.f);
            if (lane < 32) { const float rstd = 1.f / sqrtf(ssq * (1.f / 256.f) + 1e-6f); const f32x4 g0 = *(const f32x4*)(gq + 8 * c), g1 = *(const f32x4*)(gq + 8 * c + 4);
                v[0] *= rstd * g0[0]; v[1] *= rstd * g0[1]; v[2] *= rstd * g0[2]; v[3] *= rstd * g0[3]; v[4] *= rstd * g1[0]; v[5] *= rstd * g1[1]; v[6] *= rstd * g1[2]; v[7] *= rstd * g1[3];
                *(u32x4*)(cqn + (size_t)row * 256 + 8 * c) = pp_pack8(v, 1.0f); }
            else if (lane < 48) { const float rstd = 1.f / sqrtf(sskv * (1.f / 128.f) + 1e-6f); const f32x4 g0 = *(const f32x4*)(gkv + 8 * c), g1 = *(const f32x4*)(gkv + 8 * c + 4);
                v[0] *= rstd * g0[0]; v[1] *= rstd * g0[1]; v[2] *= rstd * g0[2]; v[3] *= rstd * g0[3]; v[4] *= rstd * g1[0]; v[5] *= rstd * g1[1]; v[6] *= rstd * g1[2]; v[7] *= rstd * g1[3];
                *(u32x4*)(Kc + kv * 160 + 8 * c) = pp_pack8(v, 1.0f); if (!lat) pp_store8f(out + OUT_CKV + orow * 128 + 8 * c, v); }
            else if (lane < 52) {
                if (!lat) pp_store8f(out + OUT_CKPE + orow * 32 + 8 * c, v);
                if (lat) { float pv[8]; pp_unpack8(*(const u32x4*)(pr + (src ^ 8)), pv); pp_rope8(v, pv, c & 1, tab32 + ((c < 2) ? prow : pcol) * 8); }
#pragma unroll
                for (int e = 0; e < 8; ++e) Kc[kv * 160 + 128 + rope_perm32(8 * c + e)] = f2bf(v[e]); }
        }
    }
}

__device__ __forceinline__ float a_max3(float a, float b, float c) { float r; asm("v_max3_f32 %0, %1, %2, %3" : "=v"(r) : "v"(a), "v"(b), "v"(c)); return r; }
__device__ __forceinline__ float a_max2(float a, float b) { float r; asm("v_max_f32_e32 %0, %1, %2" : "=v"(r) : "v"(a), "v"(b)); return r; }
template <int GRP> struct ACfg;
template <> struct ACfg<0> { static constexpr int NSUB = 2, KS = 2, DK = 64, DV = 64; };
template <> struct ACfg<1> { static constexpr int NSUB = 1, KS = 4, DK = 64, DV = 64; };
template <> struct ACfg<2> { static constexpr int NSUB = 1, KS = 10, DK = 160, DV = 128; };
__device__ __forceinline__ int crow(int r, int hi) { return (r & 3) + 8 * (r >> 2) + 4 * hi; }

template <int GRP>
__device__ __forceinline__ void attn_item(KPtr p, int l, bool lat, int req, int hsel, int q0, LAS unsigned char* lds) {
    constexpr int NSUB = ACfg<GRP>::NSUB, KS = ACfg<GRP>::KS, DK = ACfg<GRP>::DK, DV = ACfg<GRP>::DV, DVB = DV / 32;
    constexpr int KSTR = (DK + 8) * 2, VSTR = (GRP == 2) ? KSTR : 144, KIMG = 64 * KSTR, VIMG = (GRP == 2) ? 0 : 64 * VSTR, BUF = KIMG + VIMG;
    constexpr int KCH = DK / 8, NKC = 64 * KCH, NSLOT = (NKC + 511) / 512, VIMG_OFF = (GRP == 2) ? 0 : KIMG;
    const int tid = TID(), lane = tid & 63, wid = tid >> 6, r32 = lane & 31, hi = lane >> 5;
    unsigned char* ws = p->ws;
    const int tok0 = lat ? 8192 + req * 4096 : req * 256;
    const int kv0 = lat ? 8192 + req * 4352 : req * 256;
    int n1, nt, rbase1, rbase2;
    if (GRP == 1 && lat) { const int lo = q0 < 128 ? (128 - q0) / 64 : 0; int hiT = (4224 - q0) / 64 - 1; hiT = hiT > 4 ? 4 : hiT;
        n1 = 4; nt = 4 + hiT - lo + 1; rbase1 = kv0; rbase2 = kv0 + 256 + q0 - 128 + 64 * lo; }
    else { n1 = nt = lat ? 68 : 4; rbase1 = kv0; rbase2 = 0; }
    const bf16_t* Kg; const bf16_t* Vg; int kstride, qrow; const bf16_t* Qp;
    if (GRP == 0) { Kg = (const bf16_t*)(ws + WS_KA) + 64 * hsel; Vg = (const bf16_t*)(ws + WS_VA) + 64 * hsel; kstride = 256;
        qrow = tok0 + q0 + 32 * wid + r32; Qp = (const bf16_t*)(ws + WS_QA) + (size_t)qrow * 256 + 64 * hsel + 8 * hi; }
    else if (GRP == 1) { Kg = (const bf16_t*)(ws + WS_KB) + 64 * hsel; Vg = (const bf16_t*)(ws + WS_VB) + 64 * hsel; kstride = 128;
        qrow = tok0 + q0 + 32 * (wid & 1) + r32; Qp = (const bf16_t*)(ws + WS_QB) + (size_t)qrow * 512 + (4 * hsel + (wid >> 1)) * 64 + 8 * hi; }
    else { Kg = (const bf16_t*)(ws + WS_KC); Vg = Kg; kstride = 160;
        qrow = tok0 + q0 + 32 * (wid & 1) + r32; Qp = (const bf16_t*)(ws + WS_QC) + (size_t)qrow * 768 + 8 * hi; }
    bf16x8 qf[NSUB][KS];
#pragma unroll
    for (int s = 0; s < NSUB; ++s)
#pragma unroll
        for (int ks = 0; ks < KS; ++ks) {
            int off;
            if (GRP == 0) off = 32 * s + 16 * ks; else if (GRP == 1) off = 16 * ks; else off = (ks < 8) ? 128 * (wid >> 1) + 16 * ks : 512 + 32 * (wid >> 1) + 16 * (ks - 8);
            qf[s][ks] = __builtin_nontemporal_load((const bf16x8*)(Qp + off));
        }
    if (GRP == 2 && lat) {
        const int qp_ = q0 + 32 * (wid & 1) + r32; const f32x2* tab32 = (const f32x2*)(ws + WS_TAB32);
#pragma unroll
        for (int ks = 8; ks < 10; ++ks) { const int pos = (ks == 8) ? (qp_ >> 6) : (qp_ & 63); u32x4 w = __builtin_bit_cast(u32x4, qf[0][ks < KS ? ks : 0]); u32x4 o;
#pragma unroll
            for (int j = 0; j < 4; ++j) { const f32x2 cs = tab32[pos * 8 + 4 * hi + j]; const unsigned wj = (j == 0) ? w.x : (j == 1) ? w.y : (j == 2) ? w.z : w.w;
                const float x1 = __uint_as_float(wj << 16), x2 = __uint_as_float(wj & 0xffff0000u);
                const unsigned r = pg8::cvt_pk_bf16(x1 * cs.x - x2 * cs.y, x2 * cs.x + x1 * cs.y);
                if (j == 0) o.x = r; else if (j == 1) o.y = r; else if (j == 2) o.z = r; else o.w = r; }
            qf[0][ks < KS ? ks : 0] = __builtin_bit_cast(bf16x8, o); }
    }
    float m_run[NSUB], l_run[NSUB]; f32x16 O[NSUB][DVB];
#pragma unroll
    for (int s = 0; s < NSUB; ++s) { m_run[s] = 0.f; l_run[s] = 0.f;
#pragma unroll
        for (int d = 0; d < DVB; ++d)
#pragma unroll
            for (int r = 0; r < 16; ++r) O[s][d][r] = 0.f; }
    if (GRP == 1) { const float sk = p->in[21][l * 8 + 4 * hsel + (wid >> 1)] * LOG2E; m_run[0] = sk; l_run[0] = hi == 0 ? 1.f : 0.f; }
    const int qpos = q0 + 32 * (wid & 1) + r32;
    u32x4 kreg[NSLOT]; u32x4 vreg;
    int krow[NSLOT], kcc[NSLOT];
#pragma unroll
    for (int s = 0; s < NSLOT; ++s) { const int ci = tid + 512 * s; krow[s] = ci / KCH; kcc[s] = ci % KCH; }
#define A_TROW(i) ((i) < n1 ? rbase1 + 64 * (i) : rbase2 + 64 * ((i) - n1))
#define A_LOAD(i) do { const size_t tr_ = (size_t)A_TROW(i); \
        _Pragma("unroll") for (int s = 0; s < NSLOT; ++s) if (NKC % 512 == 0 || s < NSLOT - 1 || tid + 512 * s < NKC) kreg[s] = *(const u32x4*)(Kg + (tr_ + krow[s]) * kstride + 8 * kcc[s]); \
        if (GRP != 2) vreg = *(const u32x4*)(Vg + (tr_ + krow[0]) * kstride + 8 * kcc[0]); } while (0)
#define A_STORE(boff) do { LAS unsigned char* b_ = lds + (boff); \
        _Pragma("unroll") for (int s = 0; s < NSLOT; ++s) if (NKC % 512 == 0 || s < NSLOT - 1 || tid + 512 * s < NKC) \
            *(LAS u32x4*)(b_ + krow[s] * KSTR + kcc[s] * 16) = kreg[s]; \
        if (GRP != 2) *(LAS u32x4*)(b_ + KIMG + krow[0] * VSTR + kcc[0] * 16) = vreg; } while (0)

    f32x16 sc0[NSUB], sc1[NSUB]; bf16x8 pf[NSUB][4];
    constexpr bool NEGM = (GRP == 1);
    f32x16 negm[NSUB];
#pragma unroll
    for (int s = 0; s < NSUB; ++s) {
#pragma unroll
        for (int r = 0; r < 16; ++r) negm[s][r] = -m_run[s];
        if (NEGM) asm volatile("" : "+v"(negm[s])); }
#define A_KRD(ks_, blk_) (*(const LAS bf16x8*)(kb_ + ((blk_) * 32 + r32) * KSTR + ((s * KS + (ks_)) * 16 + 8 * hi) * 2))
#define DO_QK_S(i_, s) do { const LAS unsigned char* kb_ = lds + bo_cur; \
        { \
            if (!NEGM) { const float nm_ = -m_run[s]; _Pragma("unroll") for (int r = 0; r < 16; ++r) { sc0[s][r] = nm_; sc1[s][r] = nm_; } } \
            constexpr int KD = (GRP == 2) ? 1 : 2;        \
            bf16x8 kq[KD + 1][2]; \
            kq[0][0] = A_KRD(0, 0); kq[0][1] = A_KRD(0, 1); \
            if (KS > 1 && KD > 1) { kq[1][0] = A_KRD(1, 0); kq[1][1] = A_KRD(1, 1); } \
            _Pragma("unroll") for (int ks = 0; ks < KS; ++ks) { \
                if (ks + KD < KS) { kq[(ks + KD) % (KD + 1)][0] = A_KRD(ks + KD, 0); kq[(ks + KD) % (KD + 1)][1] = A_KRD(ks + KD, 1); } \
                __builtin_amdgcn_sched_barrier(0); \
                sc0[s] = __builtin_amdgcn_mfma_f32_32x32x16_bf16(kq[ks % (KD + 1)][0], qf[s][ks], (NEGM && ks == 0) ? negm[s] : sc0[s], 0, 0, 0); \
                sc1[s] = __builtin_amdgcn_mfma_f32_32x32x16_bf16(kq[ks % (KD + 1)][1], qf[s][ks], (NEGM && ks == 0) ? negm[s] : sc1[s], 0, 0, 0); \
                __builtin_amdgcn_sched_barrier(0); } } } while (0)
#define DO_SM_S(i_, s) do { const bool local_tile = (GRP == 1) && lat && ((i_) >= n1); const int kpos0 = local_tile ? (A_TROW(i_) - (kv0 + 256)) : 0; const bool first_ = (GRP != 1) && ((i_) == 0); \
        { \
            if (local_tile) { _Pragma("unroll") for (int r = 0; r < 16; ++r) { const int d0 = kpos0 + crow(r, hi) - qpos; const int d1 = d0 + 32; \
                if (d0 > 128 || d0 < -128) sc0[s][r] = -1e30f; if (d1 > 128 || d1 < -128) sc1[s][r] = -1e30f; } } \
            asm volatile("s_nop 15\n\ts_nop 7" : "+v"(sc0[s]), "+v"(sc1[s]));        \
            float mx = a_max3(sc0[s][0], sc1[s][0], sc0[s][1]), mxb = a_max3(sc1[s][1], sc0[s][2], sc1[s][2]); \
            _Pragma("unroll") for (int r = 3; r < 15; r += 2) { mx = a_max3(mx, sc0[s][r], sc1[s][r]); mxb = a_max3(mxb, sc0[s][r + 1], sc1[s][r + 1]); } \
            mx = a_max3(mx, sc0[s][15], sc1[s][15]); mx = a_max2(mx, mxb); \
            mx = a_max2(mx, __shfl_xor(mx, 32)); \
            if (first_) { m_run[s] = mx; _Pragma("unroll") for (int r = 0; r < 16; ++r) { sc0[s][r] -= mx; sc1[s][r] -= mx; } \
                if (NEGM) { _Pragma("unroll") for (int r = 0; r < 16; ++r) negm[s][r] = -mx; asm volatile("" : "+v"(negm[s])); } } \
            else if (__any(mx > 6.0f)) {          \
                const float dl = fmaxf(mx, 0.f); const float alpha = __builtin_amdgcn_exp2f(-dl); \
                l_run[s] *= alpha; m_run[s] += dl; \
                if (NEGM) { _Pragma("unroll") for (int r = 0; r < 16; ++r) negm[s][r] = -m_run[s]; asm volatile("" : "+v"(negm[s])); } \
                _Pragma("unroll") for (int d = 0; d < DVB; ++d) _Pragma("unroll") for (int r = 0; r < 16; ++r) O[s][d][r] *= alpha; \
                _Pragma("unroll") for (int r = 0; r < 16; ++r) { sc0[s][r] -= dl; sc1[s][r] -= dl; } } \
            float rs = 0.f; \
            _Pragma("unroll") for (int r = 0; r < 16; ++r) { sc0[s][r] = __builtin_amdgcn_exp2f(sc0[s][r]); sc1[s][r] = __builtin_amdgcn_exp2f(sc1[s][r]); rs += sc0[s][r] + sc1[s][r]; } \
            l_run[s] += rs; \
            _Pragma("unroll") for (int kk = 0; kk < 4; ++kk) { u32x4 w; \
                if (kk < 2) { const int b = 8 * kk; w.x = pg8::cvt_pk_bf16(sc0[s][b], sc0[s][b + 1]); w.y = pg8::cvt_pk_bf16(sc0[s][b + 2], sc0[s][b + 3]); w.z = pg8::cvt_pk_bf16(sc0[s][b + 4], sc0[s][b + 5]); w.w = pg8::cvt_pk_bf16(sc0[s][b + 6], sc0[s][b + 7]); } \
                else { const int b = 8 * (kk - 2); w.x = pg8::cvt_pk_bf16(sc1[s][b], sc1[s][b + 1]); w.y = pg8::cvt_pk_bf16(sc1[s][b + 2], sc1[s][b + 3]); w.z = pg8::cvt_pk_bf16(sc1[s][b + 4], sc1[s][b + 5]); w.w = pg8::cvt_pk_bf16(sc1[s][b + 6], sc1[s][b + 7]); } \
                pf[s][kk] = __builtin_bit_cast(bf16x8, w); } } } while (0)
#define A_VRD(dst, n_) do { const int d_ = (n_) % DVB, kk_ = (n_) / DVB; const LAS unsigned char* vp = vb_ + (32 * (kk_ >> 1) + 16 * (kk_ & 1)) * VSTR + 64 * d_; \
        const s16x4 lo = __builtin_bit_cast(s16x4, __builtin_amdgcn_ds_read_tr16_b64_v4i16((LAS v4i16_t*)vp)); \
        const s16x4 hi2 = __builtin_bit_cast(s16x4, __builtin_amdgcn_ds_read_tr16_b64_v4i16((LAS v4i16_t*)(vp + 8 * VSTR))); \
        dst = (bf16x8){lo[0], lo[1], lo[2], lo[3], hi2[0], hi2[1], hi2[2], hi2[3]}; } while (0)
#define DO_PV(i_) do { const LAS unsigned char* vb_ = lds + bo_cur + VIMG_OFF + (4 * hi + ((lane & 15) >> 2)) * VSTR + (16 * ((lane >> 4) & 1) + 4 * (lane & 3)) * 2; \
        constexpr int NPV = 4 * DVB; \
        _Pragma("unroll") for (int s = 0; s < NSUB; ++s) { \
            bf16x8 vq[3]; A_VRD(vq[0], 0); A_VRD(vq[1], 1); \
            _Pragma("unroll") for (int n = 0; n < NPV; ++n) { \
                if (n + 2 < NPV) A_VRD(vq[(n + 2) % 3], n + 2); \
                __builtin_amdgcn_sched_barrier(0); \
                O[s][n % DVB] = __builtin_amdgcn_mfma_f32_32x32x16_bf16(vq[n % 3], pf[s][n / DVB], O[s][n % DVB], 0, 0, 0); \
                __builtin_amdgcn_sched_barrier(0); } } } while (0)

#define A_EXPPACK_PLAIN(s) do { float rs = 0.f; \
        _Pragma("unroll") for (int r = 0; r < 16; ++r) { sc0[s][r] = __builtin_amdgcn_exp2f(sc0[s][r]); sc1[s][r] = __builtin_amdgcn_exp2f(sc1[s][r]); rs += sc0[s][r] + sc1[s][r]; } \
        l_run[s] += rs; \
        _Pragma("unroll") for (int kk = 0; kk < 4; ++kk) { u32x4 w; \
            if (kk < 2) { const int b = 8 * kk; w.x = pg8::cvt_pk_bf16(sc0[s][b], sc0[s][b + 1]); w.y = pg8::cvt_pk_bf16(sc0[s][b + 2], sc0[s][b + 3]); w.z = pg8::cvt_pk_bf16(sc0[s][b + 4], sc0[s][b + 5]); w.w = pg8::cvt_pk_bf16(sc0[s][b + 6], sc0[s][b + 7]); } \
            else { const int b = 8 * (kk - 2); w.x = pg8::cvt_pk_bf16(sc1[s][b], sc1[s][b + 1]); w.y = pg8::cvt_pk_bf16(sc1[s][b + 2], sc1[s][b + 3]); w.z = pg8::cvt_pk_bf16(sc1[s][b + 4], sc1[s][b + 5]); w.w = pg8::cvt_pk_bf16(sc1[s][b + 6], sc1[s][b + 7]); } \
            pf[s][kk] = __builtin_bit_cast(bf16x8, w); } } while (0)
#define A_PV_PLAIN(s) do { constexpr int NPV = 4 * DVB; bf16x8 vq[3]; A_VRD(vq[0], 0); A_VRD(vq[1], 1); \
        _Pragma("unroll") for (int n = 0; n < NPV; ++n) { \
            if (n + 2 < NPV) A_VRD(vq[(n + 2) % 3], n + 2); \
            __builtin_amdgcn_sched_barrier(0); \
            O[s][n % DVB] = __builtin_amdgcn_mfma_f32_32x32x16_bf16(vq[n % 3], pf[s][n / DVB], O[s][n % DVB], 0, 0, 0); \
            __builtin_amdgcn_sched_barrier(0); } } while (0)
#define A_SCE(s, e) ((e) < 16 ? sc0[s][(e) & 15] : sc1[s][(e) & 15])
#define DO_SMPV_S(i_, s) do { const bool local_tile = (GRP == 1) && lat && ((i_) >= n1); const int kpos0 = local_tile ? (A_TROW(i_) - (kv0 + 256)) : 0; \
        const LAS unsigned char* vb_ = lds + bo_prev + VIMG_OFF + (4 * hi + ((lane & 15) >> 2)) * VSTR + (16 * ((lane >> 4) & 1) + 4 * (lane & 3)) * 2; \
        { \
            if (local_tile) { _Pragma("unroll") for (int r = 0; r < 16; ++r) { const int d0 = kpos0 + crow(r, hi) - qpos; const int d1 = d0 + 32; \
                if (d0 > 128 || d0 < -128) sc0[s][r] = -1e30f; if (d1 > 128 || d1 < -128) sc1[s][r] = -1e30f; } } \
            asm volatile("s_nop 15\n\ts_nop 7" : "+v"(sc0[s]), "+v"(sc1[s]));        \
            float mx = a_max3(sc0[s][0], sc1[s][0], sc0[s][1]), mxb = a_max3(sc1[s][1], sc0[s][2], sc1[s][2]); \
            _Pragma("unroll") for (int r = 3; r < 15; r += 2) { mx = a_max3(mx, sc0[s][r], sc1[s][r]); mxb = a_max3(mxb, sc0[s][r + 1], sc1[s][r + 1]); } \
            mx = a_max3(mx, sc0[s][15], sc1[s][15]); mx = a_max2(mx, mxb); \
            mx = a_max2(mx, __shfl_xor(mx, 32)); \
            if (__any(mx > 6.0f)) {          \
                const float dl = fmaxf(mx, 0.f); const float alpha = __builtin_amdgcn_exp2f(-dl); \
                l_run[s] *= alpha; m_run[s] += dl; \
                if (NEGM) { _Pragma("unroll") for (int r = 0; r < 16; ++r) negm[s][r] = -m_run[s]; asm volatile("" : "+v"(negm[s])); } \
                _Pragma("unroll") for (int d = 0; d < DVB; ++d) _Pragma("unroll") for (int r = 0; r < 16; ++r) O[s][d][r] *= alpha; \
                _Pragma("unroll") for (int r = 0; r < 16; ++r) { sc0[s][r] -= dl; sc1[s][r] -= dl; } \
                _Pragma("unroll") for (int kk = 0; kk < 4; ++kk) { u32x4 w = __builtin_bit_cast(u32x4, pf[s][kk]); \
                    w.x = pg8::cvt_pk_bf16(__uint_as_float(w.x << 16) * alpha, __uint_as_float(w.x & 0xffff0000u) * alpha); w.y = pg8::cvt_pk_bf16(__uint_as_float(w.y << 16) * alpha, __uint_as_float(w.y & 0xffff0000u) * alpha); \
                    w.z = pg8::cvt_pk_bf16(__uint_as_float(w.z << 16) * alpha, __uint_as_float(w.z & 0xffff0000u) * alpha); w.w = pg8::cvt_pk_bf16(__uint_as_float(w.w << 16) * alpha, __uint_as_float(w.w & 0xffff0000u) * alpha); \
                    pf[s][kk] = __builtin_bit_cast(bf16x8, w); } \
            } \
            { \
                constexpr int NPV = 4 * DVB, EPM = 32 / NPV; \
                bf16x8 vq[3]; A_VRD(vq[0], 0); A_VRD(vq[1], 1); float rs = 0.f; \
                _Pragma("unroll") for (int n = 0; n < NPV; ++n) { \
                    if (n + 2 < NPV) A_VRD(vq[(n + 2) % 3], n + 2); \
                    __builtin_amdgcn_sched_barrier(0); \
                    O[s][n % DVB] = __builtin_amdgcn_mfma_f32_32x32x16_bf16(vq[n % 3], pf[s][n / DVB], O[s][n % DVB], 0, 0, 0); \
                    _Pragma("unroll") for (int e = n * EPM; e < (n + 1) * EPM; ++e) { const float x_ = __builtin_amdgcn_exp2f(A_SCE(s, e)); if (e < 16) sc0[s][e & 15] = x_; else sc1[s][e & 15] = x_; rs += x_; } \
                    if ((n + 1) % DVB == 0) { const int kk = n / DVB; const int b = 8 * (kk & 1); u32x4 w; \
                        if (kk < 2) { w.x = pg8::cvt_pk_bf16(sc0[s][b], sc0[s][b + 1]); w.y = pg8::cvt_pk_bf16(sc0[s][b + 2], sc0[s][b + 3]); w.z = pg8::cvt_pk_bf16(sc0[s][b + 4], sc0[s][b + 5]); w.w = pg8::cvt_pk_bf16(sc0[s][b + 6], sc0[s][b + 7]); } \
                        else { w.x = pg8::cvt_pk_bf16(sc1[s][b], sc1[s][b + 1]); w.y = pg8::cvt_pk_bf16(sc1[s][b + 2], sc1[s][b + 3]); w.z = pg8::cvt_pk_bf16(sc1[s][b + 4], sc1[s][b + 5]); w.w = pg8::cvt_pk_bf16(sc1[s][b + 6], sc1[s][b + 7]); } \
                        pf[s][kk] = __builtin_bit_cast(bf16x8, w); } \
                    __builtin_amdgcn_sched_barrier(0); } \
                l_run[s] += rs; \
            } } } while (0)

    int bo_prev = 2 * BUF, bo_cur = 0, bo_next = BUF;
    A_LOAD(0); A_STORE(0); if (nt > 1) A_LOAD(1);
    __syncthreads();
    if (nt > 1) { A_STORE(bo_next); if (nt > 2) A_LOAD(2); }
#pragma unroll
    for (int s = 0; s < NSUB; ++s) { DO_QK_S(0, s); DO_SM_S(0, s); }
    __syncthreads();
    for (int i = 1; i < nt; ++i) {
        { const int t_ = bo_prev; bo_prev = bo_cur; bo_cur = bo_next; bo_next = t_; }
        if (i + 1 < nt) { A_STORE(bo_next); if (i + 2 < nt) A_LOAD(i + 2); }
#pragma unroll
        for (int s = 0; s < NSUB; ++s) { DO_QK_S(i, s); DO_SMPV_S(i, s); }
        __syncthreads();
    }
    DO_PV(nt - 1);
    __syncthreads();
#undef A_KRD
#undef A_VRD
#undef DO_QK_S
#undef DO_SM_S
#undef DO_PV
#undef DO_SMPV_S
#undef A_EXPPACK_PLAIN
#undef A_PV_PLAIN
#undef A_SCE
#undef A_TROW
#undef A_LOAD
#undef A_STORE
    constexpr int SROW = (DV == 128) ? 256 : 144;
    static_assert(3 * BUF <= 65536 && 65536 + 8 * 32 * SROW <= 131072, "attention LDS map");
    LAS unsigned char* stg = lds + 65536 + wid * (32 * SROW);
    bf16_t* obase = (bf16_t*)(ws + WS_OMIX) + (size_t)(qrow - r32) * MIXK;
#define A_OUT(cb_) do { asm volatile("s_waitcnt lgkmcnt(0)" ::: "memory"); \
        _Pragma("unroll") for (int it_ = 0; it_ < DV / 16; ++it_) { const int idx_ = it_ * 64 + lane, row_ = idx_ / (DV / 8), ch_ = idx_ % (DV / 8); \
            const u32x4 v_ = *(const LAS u32x4*)(stg + row_ * SROW + ch_ * 16); *(u32x4*)(obase + (size_t)row_ * MIXK + (cb_) + 8 * ch_) = v_; } } while (0)
    if (GRP == 0) {
        const float* lp = p->in[19] + l * 128;
        float d01 = 0.f, d23 = 0.f;
#pragma unroll 8
        for (int i = 0; i < 32; ++i) { d01 += lp[i] * lp[32 + i]; d23 += lp[64 + i] * lp[96 + i]; }
        const float lam_init = l == 0 ? 0.2f : 0.35550906759096924f;
        const float lam = __expf(d01) - __expf(d23) + lam_init;
        const float i1 = 1.f / (l_run[0] + __shfl_xor(l_run[0], 32)), i2 = lam / (l_run[1] + __shfl_xor(l_run[1], 32));
        float ss = 0.f;
#pragma unroll
        for (int d = 0; d < DVB; ++d)
#pragma unroll
            for (int r = 0; r < 16; ++r) { const float v = O[0][d][r] * i1 - O[1][d][r] * i2; O[0][d][r] = v; ss += v * v; }
        ss += __shfl_xor(ss, 32);
        const float rstd = (1.f - lam_init) / sqrtf(ss * (1.f / 64.f) + 1e-6f);
        const float* sg = p->in[20] + l * 64;
#pragma unroll
        for (int d = 0; d < DVB; ++d)
#pragma unroll
            for (int g = 0; g < 4; ++g) { const int dv = 32 * d + 8 * g + 4 * hi; const f32x4 gg = *(const f32x4*)(sg + dv);
                u32x2 w; w.x = pg8::cvt_pk_bf16(O[0][d][4 * g] * rstd * gg[0], O[0][d][4 * g + 1] * rstd * gg[1]); w.y = pg8::cvt_pk_bf16(O[0][d][4 * g + 2] * rstd * gg[2], O[0][d][4 * g + 3] * rstd * gg[3]);
                *(LAS u32x2*)(stg + r32 * SROW + dv * 2) = w; }
        A_OUT(64 * hsel);
    } else {
        const float inv = 1.f / (l_run[0] + __shfl_xor(l_run[0], 32));
        const int cbase = (GRP == 1) ? 256 + (4 * hsel + (wid >> 1)) * 64 : 768 + 128 * (wid >> 1);
#pragma unroll
        for (int d = 0; d < DVB; ++d)
#pragma unroll
            for (int g = 0; g < 4; ++g) { const int dv = 32 * d + 8 * g + 4 * hi;
                u32x2 w; w.x = pg8::cvt_pk_bf16(O[0][d][4 * g] * inv, O[0][d][4 * g + 1] * inv); w.y = pg8::cvt_pk_bf16(O[0][d][4 * g + 2] * inv, O[0][d][4 * g + 3] * inv);
                *(LAS u32x2*)(stg + r32 * SROW + dv * 2) = w; }
        A_OUT(cbase);
    }
#undef A_OUT
}

__device__ __forceinline__ void phase_attn(KPtr p, int l, LAS unsigned char* lds, int it_lo, int it_hi) {
    const int nblk = NBLK(), bid = BID();
    const int vcu = (nblk % 8 == 0) ? (bid % 8) * (nblk / 8) + bid / 8 : bid;
    for (int it = vcu; it < 1536; it += nblk) {
        if (it < it_lo || it >= it_hi) continue;
        if (it < 256) attn_item<2>(p, l, true, it >> 6, 0, 64 * (it & 63), lds);
        else if (it < 512) { const int i = it - 256; attn_item<0>(p, l, true, i >> 6, (i >> 4) & 3, 256 * (i & 15), lds); }
        else if (it < 1024) { const int i = it - 512; attn_item<1>(p, l, true, i >> 7, (i >> 6) & 1, 64 * (i & 63), lds); }
        else if (it < 1152) { const int i = it - 1024; attn_item<2>(p, l, false, i >> 2, 0, 64 * (i & 3), lds); }
        else if (it < 1280) { const int i = it - 1152; attn_item<0>(p, l, false, i >> 2, i & 3, 0, lds); }
        else { const int i = it - 1280; attn_item<1>(p, l, false, i >> 3, (i >> 2) & 1, 64 * (i & 3), lds); }
    }
}

#define XB_TMO      128
#define XB_XCNT(j)  (256  + 64 * (j))
#define XB_XSUB(j)  (1280 + 64 * (j))
#define XB_XGEN(j)  (2304 + 64 * (j))
#define XB_TOP      3328
#define XB_TOPGEN   3392
#define XCD_BAR_WORDS 3456
#define XB_SPIN_CAP (1u << 18)

__device__ __forceinline__ unsigned xb_ld(unsigned* p)              { return __hip_atomic_load(p, __ATOMIC_RELAXED, __HIP_MEMORY_SCOPE_AGENT); }
__device__ __forceinline__ unsigned xb_add(unsigned* p, unsigned v) { return __hip_atomic_fetch_add(p, v, __ATOMIC_RELAXED, __HIP_MEMORY_SCOPE_AGENT); }
__device__ __forceinline__ unsigned xb_xcc_id() { return (unsigned)__builtin_amdgcn_s_getreg((3 << 11) | 20) & 0xFu; }
#define XB_SPIN(cond, bar) do { unsigned _sp = 0; while (cond) { __builtin_amdgcn_s_sleep(1); \
    if ((++_sp & 255u) == 0u) { if (xb_ld(&(bar)[XB_TMO])) break; if (_sp > XB_SPIN_CAP) { atomicAdd(&(bar)[XB_TMO], 1u); break; } } } } while (0)

struct XcdBarrier {
    unsigned* bar; unsigned x;
    volatile LAS unsigned* st;
};

__device__ __forceinline__ XcdBarrier xcd_barrier_post(unsigned* bar, volatile LAS unsigned* st) {
    XcdBarrier b; b.bar = bar; b.x = xb_xcc_id(); b.st = st;
    if (threadIdx.x == 0) (void)xb_add(&bar[XB_XCNT(b.x)], 1u);
    return b;
}
__device__ __forceinline__ void xcd_barrier_complete(unsigned* bar, unsigned x, unsigned& nloc, unsigned& nx) {
    const unsigned G = gridDim.x * gridDim.y * gridDim.z;
    unsigned sum, cnt, mine, sp = 0u;
    for (;;) {
        sum = 0u; cnt = 0u; mine = 0u;
#pragma unroll
        for (unsigned j = 0; j < 16; ++j) { const unsigned c = xb_ld(&bar[XB_XCNT(j)]); sum += c; cnt += (c > 0u) ? 1u : 0u; mine = (j == x) ? c : mine; }
        if (sum == G) break;
        __builtin_amdgcn_s_sleep(1);
        if ((++sp & 255u) == 0u) { if (xb_ld(&bar[XB_TMO])) break; if (sp > XB_SPIN_CAP) { atomicAdd(&bar[XB_TMO], 1u); break; } }
    }
    nloc = mine > 0u ? mine : 1u; nx = cnt > 0u ? cnt : 1u;
}

__device__ __forceinline__ void xcd_barrier(const XcdBarrier& b) {
    asm volatile("s_waitcnt vmcnt(0)" ::: "memory");
    __syncthreads();
    if (threadIdx.x == 0) {
        unsigned* bar = b.bar;
        __builtin_amdgcn_s_waitcnt(0);
        unsigned nloc = b.st[0], nx = b.st[1];
        if (nloc == 0u) { xcd_barrier_complete(bar, b.x, nloc, nx); b.st[0] = nloc; b.st[1] = nx; }
        const unsigned old = xb_add(&bar[XB_XSUB(b.x)], 1u);
        const unsigned gen = old / nloc;
        if (old + 1u == (gen + 1u) * nloc) {
            __builtin_amdgcn_fence(__ATOMIC_RELEASE, "agent");
            asm volatile("s_waitcnt vmcnt(0)" ::: "memory");
            const unsigned og = xb_add(&bar[XB_TOP], 1u);
            const unsigned tg = og / nx;
            if (og + 1u == (tg + 1u) * nx) xb_add(&bar[XB_TOPGEN], 1u);
            else XB_SPIN(xb_ld(&bar[XB_TOPGEN]) == tg, bar);
            __builtin_amdgcn_fence(__ATOMIC_ACQUIRE, "agent");
            xb_add(&bar[XB_XGEN(b.x)], 1u);
            asm volatile("s_waitcnt vmcnt(0)" ::: "memory");
        } else {
            XB_SPIN(xb_ld(&bar[XB_XGEN(b.x)]) == gen, bar);
            __builtin_amdgcn_fence(__ATOMIC_ACQUIRE, "agent");
            asm volatile("s_waitcnt vmcnt(0)" ::: "memory");
        }
    }
    __syncthreads();
}

constexpr int N_PHASES = 2 + 24;
__global__ void __launch_bounds__(512, 2) trunk_fwd(Params p_unused) {
    KPtr p = (KPtr)__builtin_amdgcn_kernarg_segment_ptr();
    extern __shared__ __attribute__((aligned(16))) unsigned char lds_raw[];
    LAS unsigned char* lds = (LAS unsigned char*)lds_raw;
    cg::grid_group grid = cg::this_grid();
    if (threadIdx.x < 2) ((LAS unsigned*)(lds + 131072))[threadIdx.x] = 0u;
    __syncthreads();
    (void)xcd_barrier_post((unsigned*)(p->ws + WS_BAR), (volatile LAS unsigned*)(lds + 131072));
    const int ph_lo = p->ph_lo, ph_hi = p->ph_hi;
#if defined(PROBE_SYNCS)
    for (int i = 0; i < PROBE_SYNCS; ++i) grid.sync();
#endif
#if defined(PROBE_EXTRA_N)
    for (int ph_ = ph_lo; ph_ < ph_hi + PROBE_EXTRA_N; ++ph_) {
#if defined(PROBE_DUP_AT)
        const int ph = ph_ - (ph_ > PROBE_DUP_AT ? 1 : 0);
#else
        const int ph = ph_ < ph_hi ? ph_ : PROBE_EXTRA_PH;
#endif
#else
    for (int ph = ph_lo; ph < ph_hi; ++ph) {
#endif
#if defined(PROBE_EXTRA_N)
        if (ph_ > ph_lo) {
            if (ph_ == ph_lo + 1) grid.sync();
#else
        if (ph > ph_lo) {
            if (ph == ph_lo + 1) grid.sync();
#endif
            else { XcdBarrier b; b.bar = (unsigned*)(p->ws + WS_BAR); b.x = xb_xcc_id(); b.st = (volatile LAS unsigned*)(lds + 131072); xcd_barrier(b); }
        }
        asm volatile("" : "+s"(p));
        unsigned char* ws = p->ws;
        float* mod = (float*)(ws + WS_MOD);
        #ifndef NO_PREP
        if (ph == 0) { phase_prep(p, lds); continue; }
#endif
        if (ph == 1) { phase_rows<0>(p, nullptr, nullptr, mod, mod + 1024); continue; }
        const int l = (ph - 2) / 12, k = (ph - 2) % 12;
#if defined(PROBE_K0)
        const int nrep = ((k == PROBE_K0 || k == PROBE_K1 || k == PROBE_K2) && !(k == 11 && l == 1)) ? 1 + PROBE_N : 1;
        for (int rep = 0; rep < nrep; ++rep) { if (rep) { XcdBarrier b; b.bar = (unsigned*)(p->ws + WS_BAR); b.x = xb_xcc_id(); b.st = (volatile LAS unsigned*)(lds + 131072); xcd_barrier(b); }
#endif
        const float* modl = mod + (size_t)l * 5 * 9216;
        if (k == 0 || k == 9) {
            const int lh = l * 2 + (k == 9);
            pg8::Gemm g{(const bf16_t*)(ws + WS_H), (const bf16_t*)(ws + WS_W13 + lh * W13_ONE), NTOK, 5632, 1024};
            pg8::StaticOrder S; S.init(NTOK, 5632, NBLK(), BID());
            pg8::EpiSwiGLU E{(bf16_t*)(ws + WS_G), DFF};
#ifndef NO_G1
            pg8::gemm_phase<pg8::EpiSwiGLU, pg8::StaticOrder, true, true>(lds, g, S, E);
#endif
        } else if (k == 1 || k == 10 || k == 7) {
            pg8::Gemm g; pg8::EpiResid E; E.kp = (const __attribute__((address_space(4))) pg8::RParams*)p;
            const int pli = (k == 1) ? (l * 3 - 1) : (k == 7 ? l * 3 : l * 3 + 1);
            E.lnoff = (pli + 1) * 1024;
            const int gbase = (int)(WS_MOD / 4) + l * 5 * 9216;
            if (k == 7) { g = pg8::Gemm{(const bf16_t*)(ws + WS_OMIX), (const bf16_t*)(ws + WS_WO + l * WO_ONE), NTOK, 1024, MIXK}; E.goff = gbase + 5 * 1024; E.wgt = 1.0f; }
            else { const int lh = l * 2 + (k == 10); g = pg8::Gemm{(const bf16_t*)(ws + WS_G), (const bf16_t*)(ws + WS_W2 + lh * W2_ONE), NTOK, 1024, DFF}; E.goff = gbase + (k == 1 ? 2 : 8) * 1024; E.wgt = 0.5f; }
            pg8::StaticOrder S; S.init(NTOK, 1024, NBLK(), BID());
#ifndef NO_G2
            pg8::gemm_phase<pg8::EpiResid, pg8::StaticOrder, true, true>(lds, g, S, E);
#endif
        } else if (k == 2 || k == 8 || k == 11) {
            const int li = (k == 2) ? 0 : (k == 8 ? 1 : 2);
            const float* lng = p->in[12] + (size_t)(l * 3 + li) * 1024; const float* lnb = p->in[13] + (size_t)(l * 3 + li) * 1024;
            const bool last = (k == 11 && l == 1);
            const float* mnext = (k == 11 && !last) ? mod + (size_t)(l + 1) * 5 * 9216 : modl;
            const int slot = (k == 2) ? 1 : (k == 8 ? 2 : 0);
            if (last) phase_rows<2>(p, lng, lnb, modl, modl);
            else phase_rows<1>(p, lng, lnb, mnext + (3 * slot) * 1024, mnext + (3 * slot + 1) * 1024);
        } else if (k == 3 || k == 5) {
            pg8::Gemm g; pg8::EpiStoreBf16 E;
            if (k == 3) { g = pg8::Gemm{(const bf16_t*)(ws + WS_H), (const bf16_t*)(ws + WS_WIN + l * WIN_ONE), NTOK, INWP, 1024}; E.O = (bf16_t*)(ws + WS_PROJ); E.ldc = INWP; }
            else { g = pg8::Gemm{(const bf16_t*)(ws + WS_CQN), (const bf16_t*)(ws + WS_WQ + l * WQ_ONE), NTOK, QCW, 256}; E.O = (bf16_t*)(ws + WS_QC); E.ldc = QCW; }
            pg8::StaticOrder S; S.init(NTOK, g.N, NBLK(), BID());
#ifndef NO_G3
            pg8::gemm_phase<pg8::EpiStoreBf16, pg8::StaticOrder, true, true>(lds, g, S, E);
#endif
        } else if (k == 4) {
#ifndef NO_POST
            phase_postproj(p, l);
#endif
        } else {
#ifndef NO_ATTN
#if defined(PROBE_ATT_LO)
            { const bool dup_ = (ph_ == PROBE_DUP_AT + 1); phase_attn(p, l, lds, dup_ ? PROBE_ATT_LO : 0, dup_ ? PROBE_ATT_HI : 1536); }
#else
            phase_attn(p, l, lds, 0, 1536);
#endif
#endif
        }
#if defined(PROBE_K0)
        }
#endif
    }
}

#ifndef MK_PER_PHASE
#define MK_PER_PHASE 0
#endif
extern "C" void kernel_launch(void* const* d_in, const int* in_sizes, int n_in, void* d_out, int out_size, void* d_ws, size_t ws_size, hipStream_t stream) {
    static int grid = 0;
    if (grid == 0) {
        if (n_in != 26 || ws_size < WS_END) { fprintf(stderr, "kernel_launch: need 26 inputs and %zu bytes of workspace (got %d, %zu)\n", (size_t)WS_END, n_in, ws_size); grid = -1; return; }
        int dev = 0, cus = 0, per_cu = 0;
        hipGetDevice(&dev); hipDeviceGetAttribute(&cus, hipDeviceAttributeMultiprocessorCount, dev);
        if (hipFuncSetAttribute((const void*)trunk_fwd, hipFuncAttributeMaxDynamicSharedMemorySize, LDS_BYTES) != hipSuccess) { fprintf(stderr, "kernel_launch: hipFuncSetAttribute failed\n"); grid = -1; return; }
        if (hipOccupancyMaxActiveBlocksPerMultiprocessor(&per_cu, (const void*)trunk_fwd, 512, LDS_BYTES) != hipSuccess || per_cu < 1) { fprintf(stderr, "kernel_launch: occupancy query failed (%d)\n", per_cu); per_cu = 1; }
        (void)hipGetLastError();
        grid = cus * (per_cu > 1 ? 1 : per_cu);
    }
    if (grid < 0) return;
    (void)hipMemsetAsync((char*)d_ws + WS_MOD, 0, ZERO_BYTES, stream);
    Params prm{};
    for (int i = 0; i < 26; ++i) prm.in[i] = (const float*)d_in[i];
    prm.out = (float*)d_out; prm.ws = (unsigned char*)d_ws;
#if MK_PER_PHASE
    for (int ph = 0; ph < N_PHASES; ++ph) { prm.ph_lo = ph; prm.ph_hi = ph + 1; hipLaunchKernelGGL(trunk_fwd, dim3(grid), dim3(512), LDS_BYTES, stream, prm); }
#else
    prm.ph_lo = 0; prm.ph_hi = N_PHASES;
    void* args[] = {&prm};
    hipError_t e = hipLaunchCooperativeKernel((const void*)trunk_fwd, dim3(grid), dim3(512), args, LDS_BYTES, stream);
    if (e != hipSuccess) fprintf(stderr, "cooperative launch failed: %s (grid %d)\n", hipGetErrorString(e), grid);
#endif
}
```

```cpp
#include <hip/hip_runtime.h>
#include <hip/hip_cooperative_groups.h>
#include <cstdio>
#include <cstdint>
namespace cg = cooperative_groups;
namespace pg8 {
#define PG8_LAS __attribute__((address_space(3)))
typedef unsigned short bf16_t;
typedef short bf16x8 __attribute__((ext_vector_type(8)));
typedef float f32x4 __attribute__((ext_vector_type(4)));
typedef unsigned u32x4 __attribute__((ext_vector_type(4)));
constexpr int BM = 256, BK = 64, HALF = 128, HTB = HALF * BK * 2  , STAGE_BYTES = 8 * HTB, NXCD = 8, WGM = 4;

__host__ __device__ __forceinline__ int lds_byte(int r, int c) { const int st = (r >> 4) * 2 + (c >> 5), rr = r & 15, cc = c & 31, ob = rr * 64 + cc * 2; return st * 1024 + (ob ^ (((ob >> 9) & 1) << 5)); }
__host__ __device__ __forceinline__ void stage_rc(int b, int& R, int& C) { const int st = b / 1024, sb = b % 1024, swz = sb ^ (((sb >> 9) & 1) << 5); R = (st >> 1) * 16 + swz / 64; C = (st & 1) * 32 + (swz % 64) / 2; }
__host__ __device__ __forceinline__ int perm32(int rho) { const int n = rho >> 4, i = rho & 15; return 8 * (i >> 2) + 4 * n + (i & 3); }

struct Unit { int pm, pn; };
struct Gemm { const bf16_t* A; const bf16_t* Bt; int M, N, K; };

struct StaticOrder {
    int nM, nN, nwg, G, c;
    __host__ __device__ void init(int M, int N, int G_, int c_) { nM = M / BM; nN = N / BM; nwg = nM * nN; G = G_; c = c_; }
    __host__ __device__ bool next(int i, Unit& u) const {
        const long L = (long)i * G + c; if (L >= nwg) return false;
        int wgid = (int)L; { const int q = nwg / NXCD, r = nwg % NXCD, xcd = wgid % NXCD, off = wgid / NXCD; wgid = (xcd < r ? xcd * (q + 1) : r * (q + 1) + (xcd - r) * q) + off; }
        const int nig = WGM * nN, gid = wgid / nig, fm = gid * WGM, gsz = (nM - fm) < WGM ? (nM - fm) : WGM;
        u.pm = fm + ((wgid % nig) % gsz); u.pn = (wgid % nig) / gsz; return true;
    }
    __device__ __forceinline__ void a_ready(const Unit&) const {}
    __device__ __forceinline__ void done(const Unit&) const {}
};
typedef float f32x2_t __attribute__((ext_vector_type(2)));
typedef __bf16 bf16x2_t __attribute__((ext_vector_type(2)));
__device__ __forceinline__ unsigned cvt_pk_bf16(float lo, float hi) { f32x2_t v = {lo, hi}; bf16x2_t b = __builtin_convertvector(v, bf16x2_t); return __builtin_bit_cast(unsigned, b); }
__device__ __forceinline__ float silu_f(float a) { return a * __builtin_amdgcn_rcpf(1.0f + __builtin_amdgcn_exp2f(-1.4426950408889634f * a)); }
constexpr float DN_ALPHA_F = 1.4142135623730951f;
__device__ __forceinline__ int req_of_tile(int pm) { return pm < 32 ? 0 : 1 + ((pm - 32) >> 4); }

struct EpiSwiGLU {
    static constexpr bool PERM = true, AFTER_DRAIN = false;
    bf16_t* G; int ldg;
    __device__ __forceinline__ void operator()(const f32x4 (&acc)[2][2][4][2], const Unit& u, int wr, int wc, int fr, int fq) const {
        const int row0 = u.pm * BM + wr * 64 + fr; const int col0 = u.pn * HALF + wc * 32 + 8 * fq;
#pragma unroll
        for (int ai = 0; ai < 2; ++ai)
#pragma unroll
            for (int m = 0; m < 4; ++m) {
                bf16_t* rowp = G + (size_t)(row0 + ai * HALF + m * 16) * ldg + col0;
                const f32x4 a0 = acc[ai][0][m][0], a1 = acc[ai][0][m][1], b0 = acc[ai][1][m][0], b1 = acc[ai][1][m][1];
                u32x4 w;
                w.x = cvt_pk_bf16(silu_f(a0[0]) * b0[0], silu_f(a0[1]) * b0[1]); w.y = cvt_pk_bf16(silu_f(a0[2]) * b0[2], silu_f(a0[3]) * b0[3]);
                w.z = cvt_pk_bf16(silu_f(a1[0]) * b1[0], silu_f(a1[1]) * b1[1]); w.w = cvt_pk_bf16(silu_f(a1[2]) * b1[2], silu_f(a1[3]) * b1[3]);
                *(u32x4*)rowp = w;
            }
    }
};
struct RParams { const float* in[26]; float* out; unsigned char* ws; int ph_lo, ph_hi; };
constexpr size_t RWS_LNG = 544 * 1024, RWS_STATS = 576 * 1024, RWS_LNB = 800 * 1024;
struct EpiResid {
    static constexpr bool PERM = false, AFTER_DRAIN = false;
    const __attribute__((address_space(4))) RParams* kp; int goff, lnoff; float wgt;
    __device__ __forceinline__ void operator()(const f32x4 (&acc)[2][2][4][2], const Unit& u, int wr, int wc, int fr, int fq) const {
        const int row0 = u.pm * BM + wr * 64 + fr; const int col0 = u.pn * BM + wc * 32 + 4 * fq;
        float* X = kp->out; const unsigned char* ws = kp->ws;
        const float* gp = (const float*)ws + goff + (size_t)req_of_tile(u.pm) * 9216 + col0;
        const f32x2_t* stats = (const f32x2_t*)(ws + RWS_STATS); const float* lng = (const float*)(ws + RWS_LNG) + lnoff; const float* lnb = (const float*)(ws + RWS_LNB) + lnoff;
        const float* R = (lnoff == 0) ? (u.pm < 32 ? kp->in[0] : kp->in[1] - (size_t)8192 * 1024) : (const float*)X;
        f32x4 gv[2][2], g4[2][2], b4[2][2];
#pragma unroll
        for (int bj = 0; bj < 2; ++bj)
#pragma unroll
            for (int n = 0; n < 2; ++n) { gv[bj][n] = *(const f32x4*)(gp + bj * HALF + n * 16) * wgt; g4[bj][n] = *(const f32x4*)(lng + col0 + bj * HALF + n * 16) * DN_ALPHA_F; b4[bj][n] = *(const f32x4*)(lnb + col0 + bj * HALF + n * 16) * DN_ALPHA_F; }
#pragma unroll
        for (int ai = 0; ai < 2; ++ai)
#pragma unroll
            for (int m = 0; m < 4; ++m) {
                const int row = row0 + ai * HALF + m * 16; const f32x2_t st = stats[row];
                float* rowp = X + (size_t)row * 1024 + col0;
#pragma unroll
                for (int bj = 0; bj < 2; ++bj)
#pragma unroll
                    for (int n = 0; n < 2; ++n) { f32x4* xp = (f32x4*)(rowp + bj * HALF + n * 16); const f32x4 xv = *(const f32x4*)(R + (size_t)row * 1024 + col0 + bj * HALF + n * 16);
                        *xp = ((xv - st.x) * st.y) * g4[bj][n] + b4[bj][n] + gv[bj][n] * acc[ai][bj][m][n]; }
                if (m == 3) asm volatile("" ::: "memory");
            }
    }
};
struct EpiStoreBf16 {
    static constexpr bool PERM = true, AFTER_DRAIN = false;
    bf16_t* O; int ldc;
    __device__ __forceinline__ void operator()(const f32x4 (&acc)[2][2][4][2], const Unit& u, int wr, int wc, int fr, int fq) const {
        const int row0 = u.pm * BM + wr * 64 + fr; const int col0 = u.pn * BM + wc * 32 + 8 * fq;
#pragma unroll
        for (int ai = 0; ai < 2; ++ai)
#pragma unroll
            for (int m = 0; m < 4; ++m) { bf16_t* rowp = O + (size_t)(row0 + ai * HALF + m * 16) * ldc + col0;
#pragma unroll
                for (int bj = 0; bj < 2; ++bj) { const f32x4 v0 = acc[ai][bj][m][0], v1 = acc[ai][bj][m][1];
                    u32x4 w; w.x = cvt_pk_bf16(v0[0], v0[1]); w.y = cvt_pk_bf16(v0[2], v0[3]); w.z = cvt_pk_bf16(v1[0], v1[1]); w.w = cvt_pk_bf16(v1[2], v1[3]);
                    *(u32x4*)(rowp + bj * HALF) = w; } }
    }
};
struct EpiQup {
    static constexpr bool PERM = true, AFTER_DRAIN = false;
    bf16_t* O; const f32x2_t* tab32;
    __device__ __forceinline__ void operator()(const f32x4 (&acc)[2][2][4][2], const Unit& u, int wr, int wc, int fr, int fq) const {
        const int row0 = u.pm * BM + wr * 64 + fr; const int col0 = u.pn * BM + wc * 32 + 8 * fq;
        const bool rope = (u.pn == 2) && (u.pm >= 32);
#pragma unroll
        for (int ai = 0; ai < 2; ++ai)
#pragma unroll
            for (int m = 0; m < 4; ++m) { const int row = row0 + ai * HALF + m * 16; bf16_t* rowp = O + (size_t)row * 768 + col0;
#pragma unroll
                for (int bj = 0; bj < 2; ++bj) { f32x4 v0 = acc[ai][bj][m][0], v1 = acc[ai][bj][m][1];
                    if (bj == 0 && rope) {
                        const int t = (row - 8192) & 4095; const int pos = (fq < 2) ? (t >> 6) : (t & 63); const int f0 = (4 * fq) & 7;
                        const f32x2_t* tp = tab32 + pos * 8 + f0;
                        const f32x2_t c0 = tp[0], c1 = tp[1], c2 = tp[2], c3 = tp[3];
                        f32x4 r0, r1;
                        r0[0] = v0[0] * c0.x - v0[1] * c0.y; r0[1] = v0[1] * c0.x + v0[0] * c0.y;
                        r0[2] = v0[2] * c1.x - v0[3] * c1.y; r0[3] = v0[3] * c1.x + v0[2] * c1.y;
                        r1[0] = v1[0] * c2.x - v1[1] * c2.y; r1[1] = v1[1] * c2.x + v1[0] * c2.y;
                        r1[2] = v1[2] * c3.x - v1[3] * c3.y; r1[3] = v1[3] * c3.x + v1[2] * c3.y;
                        v0 = r0; v1 = r1;
                    }
                    u32x4 w; w.x = cvt_pk_bf16(v0[0], v0[1]); w.y = cvt_pk_bf16(v0[2], v0[3]); w.z = cvt_pk_bf16(v1[0], v1[1]); w.w = cvt_pk_bf16(v1[2], v1[3]);
                    *(u32x4*)(rowp + bj * HALF) = w; }
                asm volatile("" ::: "memory"); }
    }
};

template <class Epi, class Sched, bool ALIGN_EPI = false, bool SP2 = false>
__device__ __forceinline__ void gemm_phase(PG8_LAS unsigned char* lds, const Gemm g, const Sched& S, const Epi& E) {
    int tid_ = threadIdx.x; asm volatile("" : "+v"(tid_));
    const int tid = tid_, wid = __builtin_amdgcn_readfirstlane(tid >> 6), lane = tid & 63, wr = wid >> 2, wc = wid & 3, fr = lane & 15, fq = lane >> 4;
    const int K = g.K, nt = K / BK;
    unsigned voffA[2], voffB[2];
#pragma unroll
    for (int i = 0; i < 2; ++i) { int R, C; stage_rc(tid * 16 + i * 8192, R, C); const int Rb = Epi::PERM ? ((R & ~31) + perm32(R & 31)) : R;
        voffA[i] = (unsigned)(R * K + C) * 2u; voffB[i] = (unsigned)(Rb * K + C) * 2u; }
    const size_t kstep = (size_t)(BK * 2);
    const size_t hstep = (size_t)HALF * K * 2;
    const size_t tstep = 2 * hstep;
    const unsigned ldsw = (unsigned)wid * 1024u;
    const int aoff = lds_byte(wr * 64 + fr, fq * 8), boff = lds_byte(wc * 32 + fr, fq * 8);
#define PG8_SA(b, h) (((b) * 2 + (h)) * HTB)
#define PG8_SB(b, h) ((4 + (b) * 2 + (h)) * HTB)
#define PG8_STAGE(bufoff, gbase, voff) do { _Pragma("unroll") for (int _i = 0; _i < 2; ++_i) \
        __builtin_amdgcn_global_load_lds((const unsigned*)((const char*)(gbase) + (voff)[_i]), (PG8_LAS unsigned*)(lds + (bufoff) + ldsw + _i * 8192), 16, 0, 0); } while (0)
#define PG8_LDA(dst, b, h) do { _Pragma("unroll") for (int m = 0; m < 4; ++m) _Pragma("unroll") for (int k = 0; k < 2; ++k) dst[m][k] = *(const PG8_LAS bf16x8*)(lds + PG8_SA(b, h) + aoff + m * 2048 + k * 1024); } while (0)
#define PG8_LDB(dst, b, h) do { _Pragma("unroll") for (int n = 0; n < 2; ++n) _Pragma("unroll") for (int k = 0; k < 2; ++k) dst[n][k] = *(const PG8_LAS bf16x8*)(lds + PG8_SB(b, h) + boff + n * 2048 + k * 1024); } while (0)
#define PG8_MMA(ai, bj, At, Bt) do { __builtin_amdgcn_s_setprio(1); _Pragma("unroll") for (int m = 0; m < 4; ++m) _Pragma("unroll") for (int n = 0; n < 2; ++n) _Pragma("unroll") for (int k = 0; k < 2; ++k) \
        acc[ai][bj][m][n] = __builtin_amdgcn_mfma_f32_16x16x32_bf16(Bt[n][k], At[m][k], acc[ai][bj][m][n], 0, 0, 0); __builtin_amdgcn_s_setprio(0); } while (0)
#define PG8_WAIT_V(n) asm volatile("s_waitcnt vmcnt(" #n ")" ::: "memory")
#define PG8_WAIT_L(n) asm volatile("s_waitcnt lgkmcnt(" #n ")" ::: "memory")
#define PG8_BAR __builtin_amdgcn_s_barrier()
#define PG8_SCHED __builtin_amdgcn_sched_barrier(0)
    Unit cur, nxt; int ui = 0;
    if (!S.next(0, cur)) return;
    f32x4 acc[2][2][4][2];
#pragma unroll
    for (int a = 0; a < 2; ++a)
#pragma unroll
        for (int b = 0; b < 2; ++b)
#pragma unroll
            for (int m = 0; m < 4; ++m)
#pragma unroll
                for (int n = 0; n < 2; ++n) acc[a][b][m][n] = (f32x4){0.f, 0.f, 0.f, 0.f};
    bf16x8 At[4][2], B0[2][2], B1[2][2];
    const char* cA = (const char*)g.A + (size_t)cur.pm * tstep; const char* cB = (const char*)g.Bt + (size_t)cur.pn * tstep;
    S.a_ready(cur);
    if constexpr (SP2) {
        PG8_STAGE(PG8_SB(0, 0), cB, voffB); PG8_STAGE(PG8_SB(0, 1), cB + hstep, voffB); PG8_STAGE(PG8_SA(0, 0), cA, voffA); PG8_STAGE(PG8_SA(0, 1), cA + hstep, voffA);
        if (wr == 1) PG8_BAR;
        PG8_WAIT_V(2); PG8_BAR;
        PG8_STAGE(PG8_SB(1, 0), cB + kstep, voffB); PG8_STAGE(PG8_SA(1, 0), cA + kstep, voffA); PG8_STAGE(PG8_SB(1, 1), cB + hstep + kstep, voffB);
        PG8_WAIT_V(6); PG8_BAR;
    } else {
        PG8_STAGE(PG8_SB(0, 0), cB, voffB); PG8_STAGE(PG8_SA(0, 0), cA, voffA); PG8_STAGE(PG8_SB(0, 1), cB + hstep, voffB); PG8_STAGE(PG8_SA(0, 1), cA + hstep, voffA);
        if (wr == 1) PG8_BAR;
        PG8_WAIT_V(4); PG8_BAR;
        PG8_STAGE(PG8_SB(1, 0), cB + kstep, voffB); PG8_STAGE(PG8_SA(1, 0), cA + kstep, voffA); PG8_STAGE(PG8_SB(1, 1), cB + hstep + kstep, voffB);
        PG8_WAIT_V(6); PG8_BAR;
    }
    for (;;) {
        const bool has_next = S.next(ui + 1, nxt);
        const char* nA = has_next ? (const char*)g.A + (size_t)nxt.pm * tstep : cA; const char* nB = has_next ? (const char*)g.Bt + (size_t)nxt.pn * tstep : cB;
        for (int t = 0; t < nt; t += 2) {
            const bool last = (t == nt - 2);
            const char* a1 = cA + (size_t)(t + 1) * kstep;
            const char* a2 = last ? nA : cA + (size_t)(t + 2) * kstep; const char* b2 = last ? nB : cB + (size_t)(t + 2) * kstep;
            const char* a3 = a2 + kstep; const char* b3 = b2 + kstep;
            if (last && has_next) S.a_ready(nxt);
            if constexpr (SP2) {
            PG8_LDB(B0, 0, 0); PG8_LDB(B1, 0, 1); PG8_SCHED; PG8_LDA(At, 0, 0); PG8_STAGE(PG8_SA(1, 1), a1 + hstep, voffA);
            PG8_WAIT_V(8); PG8_WAIT_L(0); PG8_BAR; PG8_MMA(0, 0, At, B0); PG8_MMA(0, 1, At, B1); PG8_BAR; PG8_SCHED;
            PG8_LDA(At, 0, 1); PG8_STAGE(PG8_SB(0, 0), b2, voffB); PG8_STAGE(PG8_SB(0, 1), b2 + hstep, voffB); PG8_STAGE(PG8_SA(0, 0), a2, voffA);
            PG8_WAIT_V(8); PG8_WAIT_L(0); PG8_BAR; PG8_MMA(1, 0, At, B0); PG8_MMA(1, 1, At, B1); PG8_BAR; PG8_SCHED;
            PG8_LDB(B0, 1, 0); PG8_LDB(B1, 1, 1); PG8_SCHED; PG8_LDA(At, 1, 0); PG8_STAGE(PG8_SA(0, 1), a2 + hstep, voffA);
            PG8_WAIT_V(8); PG8_WAIT_L(0); PG8_BAR; PG8_MMA(0, 0, At, B0); PG8_MMA(0, 1, At, B1); PG8_BAR; PG8_SCHED;
            PG8_LDA(At, 1, 1); PG8_STAGE(PG8_SB(1, 0), b3, voffB); PG8_STAGE(PG8_SB(1, 1), b3 + hstep, voffB); PG8_STAGE(PG8_SA(1, 0), a3, voffA);
            PG8_WAIT_V(8); PG8_WAIT_L(0); PG8_BAR; PG8_MMA(1, 0, At, B0); PG8_MMA(1, 1, At, B1); PG8_BAR; PG8_SCHED;
            } else {
            PG8_LDB(B0, 0, 0); PG8_SCHED; PG8_LDA(At, 0, 0); PG8_STAGE(PG8_SA(1, 1), a1 + hstep, voffA);
            PG8_WAIT_L(8); PG8_BAR; PG8_WAIT_L(0); PG8_MMA(0, 0, At, B0); PG8_BAR; PG8_SCHED;
            PG8_LDB(B1, 0, 1); PG8_STAGE(PG8_SB(0, 0), b2, voffB);
            PG8_BAR; PG8_WAIT_L(0); PG8_MMA(0, 1, At, B1); PG8_BAR;
            PG8_LDA(At, 0, 1); PG8_STAGE(PG8_SA(0, 0), a2, voffA);
            PG8_BAR; PG8_WAIT_L(0); PG8_MMA(1, 0, At, B0); PG8_BAR; PG8_SCHED;
            PG8_STAGE(PG8_SB(0, 1), b2 + hstep, voffB);
            PG8_WAIT_V(6); PG8_BAR; PG8_MMA(1, 1, At, B1); PG8_BAR;
            PG8_LDB(B0, 1, 0); PG8_SCHED; PG8_LDA(At, 1, 0); PG8_STAGE(PG8_SA(0, 1), a2 + hstep, voffA);
            PG8_WAIT_L(8); PG8_BAR; PG8_WAIT_L(0); PG8_MMA(0, 0, At, B0); PG8_BAR; PG8_SCHED;
            PG8_LDB(B1, 1, 1); PG8_STAGE(PG8_SB(1, 0), b3, voffB);
            PG8_BAR; PG8_WAIT_L(0); PG8_MMA(0, 1, At, B1); PG8_BAR;
            PG8_LDA(At, 1, 1); PG8_STAGE(PG8_SA(1, 0), a3, voffA);
            PG8_BAR; PG8_WAIT_L(0); PG8_MMA(1, 0, At, B0); PG8_BAR; PG8_SCHED;
            PG8_STAGE(PG8_SB(1, 1), b3 + hstep, voffB);
            PG8_WAIT_V(6); PG8_BAR; PG8_MMA(1, 1, At, B1); PG8_BAR;
            }
        }
        if constexpr (ALIGN_EPI) { if (wr == 0) PG8_BAR; }
        if constexpr (!Epi::AFTER_DRAIN) { E(acc, cur, wr, wc, fr, fq); S.done(cur); }
        if (!has_next) break;
#pragma unroll
        for (int a = 0; a < 2; ++a)
#pragma unroll
            for (int b = 0; b < 2; ++b)
#pragma unroll
                for (int m = 0; m < 4; ++m)
#pragma unroll
                    for (int n = 0; n < 2; ++n) acc[a][b][m][n] = (f32x4){0.f, 0.f, 0.f, 0.f};
        cur = nxt; cA = nA; cB = nB; ++ui;
        if constexpr (ALIGN_EPI) { if (wr == 1) PG8_BAR; }
    }
    PG8_WAIT_V(0);
    if constexpr (!ALIGN_EPI) { if (wr == 0) PG8_BAR; }
    PG8_BAR;
    if constexpr (Epi::AFTER_DRAIN) { E.fused(acc, cur, wr, wc, fr, fq, lds, wid, lane); S.done(cur); }
#undef PG8_SA
#undef PG8_SB
#undef PG8_STAGE
#undef PG8_LDA
#undef PG8_LDB
#undef PG8_MMA
#undef PG8_WAIT_V
#undef PG8_WAIT_L
#undef PG8_BAR
#undef PG8_SCHED
}
}

#define LAS __attribute__((address_space(3)))
typedef unsigned short bf16_t;
typedef short bf16x8 __attribute__((ext_vector_type(8)));
typedef short s16x4 __attribute__((ext_vector_type(4)));
typedef short v4i16_t __attribute__((ext_vector_type(4)));
typedef float f32x4 __attribute__((ext_vector_type(4)));
typedef float f32x2 __attribute__((ext_vector_type(2)));
typedef float f32x16 __attribute__((ext_vector_type(16)));
typedef unsigned u32x4 __attribute__((ext_vector_type(4)));
typedef unsigned u32x2 __attribute__((ext_vector_type(2)));

constexpr int NTOK = 24576, NPTOK = 8192;
constexpr int DM = 1024, DFF = 2816, INW = 1952, INWP = 2048, MIXK = 1280, QCW = 768;
constexpr int KVROWS = 8192 + 4 * 4352;
constexpr float LOG2E = 1.4426950408889634f;
constexpr float QSC_A = 0.17677669529663687f * LOG2E;
constexpr float QSC_B = 0.125f * LOG2E;
constexpr float QSC_C = 0.10206207261596575f * LOG2E;

constexpr size_t WS_MOD = 0;
constexpr size_t MOD_BYTES = 2 * 5 * 9216 * 4;
constexpr size_t WS_BAR = 384 * 1024;
constexpr size_t ZERO_BYTES = WS_BAR + 3456 * 4;
constexpr size_t WS_TAB32 = 512 * 1024;
constexpr size_t WS_TAB64 = WS_TAB32 + 8192;
constexpr size_t WS_LNG = 544 * 1024, WS_LNB = 800 * 1024;
constexpr size_t WS_STATS = 576 * 1024;
constexpr size_t WS_W13 = 1048576;
constexpr size_t W13_ONE = (size_t)5632 * 1024 * 2;
constexpr size_t WS_W2 = WS_W13 + 4 * W13_ONE;
constexpr size_t W2_ONE = (size_t)1024 * 2816 * 2;
constexpr size_t WS_WIN = WS_W2 + 4 * W2_ONE;
constexpr size_t WIN_ONE = (size_t)2048 * 1024 * 2;
constexpr size_t WS_WO = WS_WIN + 2 * WIN_ONE;
constexpr size_t WO_ONE = (size_t)1024 * 1280 * 2;
constexpr size_t WS_WQ = WS_WO + 2 * WO_ONE;
constexpr size_t WQ_ONE = (size_t)768 * 256 * 2;
constexpr size_t WS_H = WS_WQ + 2 * WQ_ONE;
constexpr size_t WS_QA = WS_H, WS_QB = WS_QA + (size_t)NTOK * 256 * 2, WS_CQN = WS_QB + (size_t)NTOK * 512 * 2;
constexpr size_t WS_G = WS_H + (size_t)NTOK * 1024 * 2;
constexpr size_t WS_PROJ = WS_G, WS_QC = WS_G, WS_OMIX = WS_G + (size_t)NTOK * 768 * 2;
constexpr size_t WS_KA = WS_G + (size_t)NTOK * 2816 * 2;
constexpr size_t WS_VA = WS_KA + (size_t)KVROWS * 256 * 2;
constexpr size_t WS_KB = WS_VA + (size_t)KVROWS * 256 * 2;
constexpr size_t WS_VB = WS_KB + (size_t)KVROWS * 128 * 2;
constexpr size_t WS_KC = WS_VB + (size_t)KVROWS * 128 * 2;
constexpr size_t WS_END = WS_KC + (size_t)KVROWS * 160 * 2;
static_assert(WS_CQN + (size_t)NTOK * 256 * 2 == WS_G, "Q overlay fills H exactly");
static_assert(WS_OMIX + (size_t)NTOK * 1280 * 2 <= WS_KA, "omix inside G region");

constexpr size_t OUT_Y = 0;
constexpr size_t OUT_AK = 25165824, OUT_AV = 29360128, OUT_BK = 33554432, OUT_BV = 35651584, OUT_CKV = 37748736, OUT_CKPE = 39845888;

constexpr int LDS_BYTES = 131072 + 1024;

struct Params { const float* in[26]; float* out; unsigned char* ws; int ph_lo, ph_hi; };
static_assert(sizeof(Params) == sizeof(pg8::RParams) && WS_LNG == pg8::RWS_LNG && WS_LNB == pg8::RWS_LNB && WS_STATS == pg8::RWS_STATS, "epilogue's view of the frame");
typedef const __attribute__((address_space(4))) Params* KPtr;

__device__ __forceinline__ int TID() { int t = threadIdx.x; asm volatile("" : "+v"(t)); return t; }
__device__ __forceinline__ int BID() { int t = blockIdx.x; asm volatile("" : "+s"(t)); return t; }
__device__ __forceinline__ int NBLK() { int t = gridDim.x; asm volatile("" : "+s"(t)); return t; }
__device__ __forceinline__ float bf2f(bf16_t b) { return __uint_as_float((unsigned)b << 16); }
__device__ __forceinline__ bf16_t f2bf(float f) { return (bf16_t)(pg8::cvt_pk_bf16(f, 0.f) & 0xffffu); }
__device__ __forceinline__ float wave_sum(float v) {
#pragma unroll
    for (int o = 1; o < 64; o <<= 1) v += __shfl_xor(v, o);
    return v;
}
__device__ __forceinline__ int rope_perm32(int d) { const int e = (d >> 3) & 1, p = (d & 7) + ((d & 16) >> 1); return 2 * p + e; }
__device__ __forceinline__ int rope_unperm32(int rho) { const int p = rho >> 1, e = rho & 1; return ((p & 8) << 1) + (p & 7) + 8 * e; }

__device__ __forceinline__ void transpose_item(const float* W, int N, bf16_t* WT, int ldk, int k0, int n0, int drow0, LAS float* scr, int lane) {
    float tv[32];
#pragma unroll
    for (int i = 0; i < 32; ++i) tv[i] = __builtin_nontemporal_load(&W[(size_t)(k0 + 2 * i + (lane >> 5)) * N + n0 + (lane & 31)]);
#pragma unroll
    for (int i = 0; i < 32; ++i) scr[(2 * i + (lane >> 5)) * 33 + (lane & 31)] = tv[i];
    asm volatile("s_waitcnt lgkmcnt(0)" ::: "memory");
    const int c = lane & 7;
#pragma unroll
    for (int j = 0; j < 4; ++j) { const int n = (lane >> 3) + 8 * j; const LAS float* s = scr + (8 * c) * 33 + n;
        u32x4 o; o.x = pg8::cvt_pk_bf16(s[0 * 33], s[1 * 33]); o.y = pg8::cvt_pk_bf16(s[2 * 33], s[3 * 33]); o.z = pg8::cvt_pk_bf16(s[4 * 33], s[5 * 33]); o.w = pg8::cvt_pk_bf16(s[6 * 33], s[7 * 33]);
        *(u32x4*)(WT + (size_t)(drow0 + n) * ldk + k0 + 8 * c) = o; }
    asm volatile("s_waitcnt lgkmcnt(0)" ::: "memory");
}

__device__ __forceinline__ void phase_prep(KPtr p, LAS unsigned char* lds) {
    const int tid = TID(), lane = tid & 63, wave = tid >> 6, bid = BID(), nblk = NBLK();
    const int gw = bid * 8 + wave, NGW = nblk * 8;
    const int gt = bid * 512 + tid, NGT = nblk * 512;
    unsigned char* ws = p->ws;
    {
        float* mod = (float*)(ws + WS_MOD);
        const float* cctx = p->in[9]; const float* cc4 = p->in[8];
        for (int it = gw; it < 2 * 32 * 36; it += NGW) {
            const int l = it / (32 * 36), r = it % (32 * 36), kc = r / 36, cc = r % 36;
            const int col = cc * 256 + lane * 4;
            const float* W = p->in[10] + ((size_t)l * 1024 + kc * 32) * 9216 + col;
            f32x4 a0 = {0.f, 0.f, 0.f, 0.f}, a1 = a0, a2 = a0, a3 = a0, a4 = a0;
#pragma unroll 8
            for (int k = 0; k < 32; ++k) {
                const f32x4 w = __builtin_nontemporal_load((const f32x4*)(W + (size_t)k * 9216));
                const int kk = kc * 32 + k;
                const float c0 = cctx[kk], c1 = cc4[kk], c2 = cc4[1024 + kk], c3 = cc4[2048 + kk], c4 = cc4[3072 + kk];
                a0 += w * (c0 / (1.f + __expf(-c0))); a1 += w * (c1 / (1.f + __expf(-c1))); a2 += w * (c2 / (1.f + __expf(-c2)));
                a3 += w * (c3 / (1.f + __expf(-c3))); a4 += w * (c4 / (1.f + __expf(-c4)));
            }
            if (kc == 0) { const f32x4 bv = *(const f32x4*)(p->in[11] + (size_t)l * 9216 + col); a0 += bv; a1 += bv; a2 += bv; a3 += bv; a4 += bv; }
            float* m0 = mod + (size_t)(l * 5) * 9216 + col;
#pragma unroll
            for (int e = 0; e < 4; ++e) { atomicAdd(m0 + e, a0[e]); atomicAdd(m0 + 9216 + e, a1[e]); atomicAdd(m0 + 2 * 9216 + e, a2[e]); atomicAdd(m0 + 3 * 9216 + e, a3[e]); atomicAdd(m0 + 4 * 9216 + e, a4[e]); }
        }
    }
    {
        LAS float* scr = (LAS float*)(lds + wave * 8704);
        constexpr int I13 = 16 * 88, I2 = 44 * 32, IIN = 16 * 61, IO = 12 * 32;
        constexpr int T13 = 8 * I13, T2 = 4 * I2, TIN = 2 * IIN, TO = 2 * IO;
        for (int it = gw; it < T13 + T2 + TIN + TO; it += NGW) {
            int r = it;
            if (r < T13) { const int mtx = r / I13, i = r % I13, lh = mtx >> 1, s = mtx & 1; const int kb = i / 88, nb = i % 88, n0 = nb * 32;
                transpose_item(p->in[s ? 15 : 14] + (size_t)lh * 1024 * 2816, 2816, (bf16_t*)(ws + WS_W13 + lh * W13_ONE), 1024, kb * 64, n0, (n0 >> 7) * 256 + s * 128 + (n0 & 127), scr, lane); continue; }
            r -= T13;
            if (r < T2) { const int lh = r / I2, i = r % I2; const int kb = i / 32, nb = i % 32;
                transpose_item(p->in[16] + (size_t)lh * 2816 * 1024, 1024, (bf16_t*)(ws + WS_W2 + lh * W2_ONE), 2816, kb * 64, nb * 32, nb * 32, scr, lane); continue; }
            r -= T2;
            if (r < TIN) { const int l = r / IIN, i = r % IIN; const int kb = i / 61, nb = i % 61;
                transpose_item(p->in[17] + (size_t)l * 1024 * 1952, 1952, (bf16_t*)(ws + WS_WIN + l * WIN_ONE), 1024, kb * 64, nb * 32, nb * 32, scr, lane); continue; }
            r -= TIN;
            { const int l = r / IO, i = r % IO; const int kb = i / 32, nb = i % 32;
                transpose_item(p->in[18] + (size_t)l * 1024 * 1024, 1024, (bf16_t*)(ws + WS_WO + l * WO_ONE), 1280, kb * 64, nb * 32, nb * 32, scr, lane); }
        }
    }
    for (int i = gt; i < 2 * 96 * 1024 / 8; i += NGT) { const int l = i / (96 * 128), r = i % (96 * 128);
        *(u32x4*)(ws + WS_WIN + l * WIN_ONE + (size_t)1952 * 2048 + (size_t)r * 16) = (u32x4){0u, 0u, 0u, 0u}; }
    for (int i = gt; i < 2 * 512 * 1024; i += NGT) {
        const int l = i >> 19, kk = (i >> 10) & 511, n = i & 1023, h = kk >> 7, c = kk & 127;
        const float* uv = p->in[25] + ((size_t)(l * 128 + c) * 4 + h) * 128 + 64;
        const float* wo = p->in[18] + ((size_t)l * 1024 + 768 + 64 * h) * 1024 + n;
        float s = 0.f;
#pragma unroll 16
        for (int d = 0; d < 64; ++d) s += uv[d] * wo[(size_t)d * 1024];
        ((bf16_t*)(ws + WS_WO + l * WO_ONE))[(size_t)n * 1280 + 768 + kk] = f2bf(s);
    }
    for (int i = gt; i < 2 * 256 * 768; i += NGT) {
        const int l = i / (256 * 768), r = i % (256 * 768), k = r / 768, n = r % 768;
        const float* qu = p->in[23] + ((size_t)l * 256 + k) * 384;
        float s = 0.f;
        if (n < 512) { const int h = n >> 7, c = n & 127; const float* uk = p->in[25] + ((size_t)(l * 128 + c) * 4 + h) * 128;
#pragma unroll 4
            for (int d = 0; d < 64; d += 4) { const f32x4 a = *(const f32x4*)(uk + d), b = *(const f32x4*)(qu + 96 * h + d); s += (a[0] * b[0] + a[1] * b[1]) + (a[2] * b[2] + a[3] * b[3]); } }
        else if (n < 640) { const int h = (n - 512) >> 5, rho = (n - 512) & 31; s = qu[96 * h + 64 + rope_unperm32(rho)]; }
        ((bf16_t*)(ws + WS_WQ + l * WQ_ONE))[(size_t)n * 256 + k] = f2bf(s * QSC_C);
    }
    for (int i = gt; i < 7 * 1024; i += NGT) { ((float*)(ws + WS_LNG))[i] = i < 1024 ? 1.0f : p->in[12][i - 1024]; ((float*)(ws + WS_LNB))[i] = i < 1024 ? 0.0f : p->in[13][i - 1024]; }
    for (int i = gt; i < 64 * 8 + 64 * 16; i += NGT) {
        if (i < 512) { const int pos = i >> 3, f = i & 7; const float inv = exp2f(-(float)(2 * f) / 16.0f * 13.287712379549449f); const float a = (float)pos * inv;
            ((f32x2*)(ws + WS_TAB32))[i] = (f32x2){cosf(a), sinf(a)}; }
        else { const int j = i - 512, pos = j >> 4, f = j & 15; const float inv = exp2f(-(float)(2 * f) / 32.0f * 13.287712379549449f); const float a = (float)pos * inv;
            ((f32x2*)(ws + WS_TAB64))[j] = (f32x2){cosf(a), sinf(a)}; }
    }
}

template <int MODE>
__device__ __forceinline__ void rows_load(KPtr p, int row, int lane, f32x4 (&v)[4]) {
    const float* src;
    if (MODE == 0) src = (row < NPTOK ? p->in[0] + (size_t)row * DM : p->in[1] + (size_t)(row - NPTOK) * DM) + lane * 4;
    else src = p->out + OUT_Y + (size_t)row * DM + lane * 4;
#pragma unroll
    for (int j = 0; j < 4; ++j) v[j] = __builtin_nontemporal_load((const f32x4*)(src + 256 * j));
}
template <int MODE>
__device__ __forceinline__ void rows_finish(KPtr p, int row, int lane, f32x4 (&v)[4], const float* lng, const float* lnb, const float* shift, const float* scale) {
    const int req = row < NPTOK ? 0 : 1 + ((row - NPTOK) >> 12);
    float* xr = p->out + OUT_Y + (size_t)row * DM + lane * 4; f32x2* stats = (f32x2*)(p->ws + WS_STATS);
    if (MODE == 0) {
        if (lane == 0) stats[row] = (f32x2){0.f, 1.f};
    } else {
        float s = 0.f;
#pragma unroll
        for (int j = 0; j < 4; ++j) s += (v[j].x + v[j].y) + (v[j].z + v[j].w);
        const float mean = wave_sum(s) * (1.f / DM); float s2 = 0.f;
#pragma unroll
        for (int j = 0; j < 4; ++j) { v[j] = v[j] - mean; s2 += (v[j].x * v[j].x + v[j].y * v[j].y) + (v[j].z * v[j].z + v[j].w * v[j].w); }
        const float rstd = 1.f / sqrtf(wave_sum(s2) * (1.f / DM) + 1e-5f);
        if (MODE == 1 && lane == 0) stats[row] = (f32x2){mean, rstd};
#pragma unroll
        for (int j = 0; j < 4; ++j) { const f32x4 g = *(const f32x4*)(lng + lane * 4 + 256 * j), b = *(const f32x4*)(lnb + lane * 4 + 256 * j);
            v[j] = v[j] * rstd * g + b; if (MODE == 2) __builtin_nontemporal_store(v[j], (f32x4*)(xr + 256 * j)); }
    }
    if (MODE != 2) {
        const float* sh = shift + (size_t)req * 9216 + lane * 4; const float* sc = scale + (size_t)req * 9216 + lane * 4;
        bf16_t* hr = (bf16_t*)(p->ws + WS_H) + (size_t)row * DM + lane * 4;
#pragma unroll
        for (int j = 0; j < 4; ++j) { const f32x4 a = *(const f32x4*)(sc + 256 * j), b = *(const f32x4*)(sh + 256 * j); const f32x4 h = v[j] * (a + 1.0f) + b;
            u32x2 w; w.x = pg8::cvt_pk_bf16(h[0], h[1]); w.y = pg8::cvt_pk_bf16(h[2], h[3]); *(u32x2*)(hr + 256 * j) = w; }
    }
}
template <int MODE>
__device__ __forceinline__ void phase_rows(KPtr p, const float* lng, const float* lnb, const float* shift, const float* scale) {
    const int tid = TID(), lane = tid & 63, wave = tid >> 6;
    const int gw = BID() * 8 + wave, NGW = NBLK() * 8;
    for (int row0 = gw; row0 < NTOK; row0 += 4 * NGW) {
        const int row1 = row0 + NGW, row2 = row0 + 2 * NGW, row3 = row0 + 3 * NGW;
        const bool ok1 = row1 < NTOK, ok2 = row2 < NTOK, ok3 = row3 < NTOK;
        f32x4 va[4], vb[4], vc[4], vd[4];
        rows_load<MODE>(p, row0, lane, va);
        if (ok1) rows_load<MODE>(p, row1, lane, vb);
        if (ok2) rows_load<MODE>(p, row2, lane, vc);
        if (ok3) rows_load<MODE>(p, row3, lane, vd);
        rows_finish<MODE>(p, row0, lane, va, lng, lnb, shift, scale);
        if (ok1) rows_finish<MODE>(p, row1, lane, vb, lng, lnb, shift, scale);
        if (ok2) rows_finish<MODE>(p, row2, lane, vc, lng, lnb, shift, scale);
        if (ok3) rows_finish<MODE>(p, row3, lane, vd, lng, lnb, shift, scale);
    }
}

__device__ __forceinline__ float rope32_val(const bf16_t* seg, int d, const f32x2* tab32, int prow, int pcol) {
    const float v = bf2f(seg[d]), pv = bf2f(seg[d ^ 8]);
    const f32x2 cs = tab32[((d < 16) ? prow : pcol) * 8 + (d & 7)];
    return (d & 8) ? (v * cs.x + pv * cs.y) : (v * cs.x - pv * cs.y);
}
__device__ __forceinline__ float rope64_val(const bf16_t* seg, int d, const f32x2* tab64, int prow, int pcol) {
    const float v = bf2f(seg[d]), pv = bf2f(seg[d ^ 16]);
    const f32x2 cs = tab64[((d < 32) ? prow : pcol) * 16 + (d & 15)];
    return (d & 16) ? (v * cs.x + pv * cs.y) : (v * cs.x - pv * cs.y);
}
__device__ __forceinline__ void pp_unpack8(u32x4 w, float (&f)[8]) {
    f[0] = __uint_as_float(w.x << 16); f[1] = __uint_as_float(w.x & 0xffff0000u); f[2] = __uint_as_float(w.y << 16); f[3] = __uint_as_float(w.y & 0xffff0000u);
    f[4] = __uint_as_float(w.z << 16); f[5] = __uint_as_float(w.z & 0xffff0000u); f[6] = __uint_as_float(w.w << 16); f[7] = __uint_as_float(w.w & 0xffff0000u); }
__device__ __forceinline__ u32x4 pp_pack8(const float (&f)[8], float sc) { u32x4 w; w.x = pg8::cvt_pk_bf16(f[0] * sc, f[1] * sc); w.y = pg8::cvt_pk_bf16(f[2] * sc, f[3] * sc); w.z = pg8::cvt_pk_bf16(f[4] * sc, f[5] * sc); w.w = pg8::cvt_pk_bf16(f[6] * sc, f[7] * sc); return w; }
__device__ __forceinline__ void pp_store8f(float* o, const float (&f)[8]) { __builtin_nontemporal_store((f32x4){f[0], f[1], f[2], f[3]}, (f32x4*)o); __builtin_nontemporal_store((f32x4){f[4], f[5], f[6], f[7]}, (f32x4*)(o + 4)); }
__device__ __forceinline__ void pp_rope8(float (&v)[8], const float (&pv)[8], int second, const f32x2* cs) {
#pragma unroll
    for (int e = 0; e < 8; ++e) { const f32x2 c = cs[e]; v[e] = second ? (v[e] * c.x + pv[e] * c.y) : (v[e] * c.x - pv[e] * c.y); } }
__device__ __forceinline__ void phase_postproj(KPtr p, int l) {
    const int tid = TID(), lane = tid & 63, wave = tid >> 6;
    const int gw = BID() * 8 + wave, NGW = NBLK() * 8;
    unsigned char* ws = p->ws;
    const bf16_t* proj = (const bf16_t*)(ws + WS_PROJ);
    bf16_t *Qa = (bf16_t*)(ws + WS_QA), *Qb = (bf16_t*)(ws + WS_QB), *cqn = (bf16_t*)(ws + WS_CQN);
    bf16_t *Ka = (bf16_t*)(ws + WS_KA), *Va = (bf16_t*)(ws + WS_VA), *Kb = (bf16_t*)(ws + WS_KB), *Vb = (bf16_t*)(ws + WS_VB), *Kc = (bf16_t*)(ws + WS_KC);
    const f32x2* tab32 = (const f32x2*)(ws + WS_TAB32); const f32x2* tab64 = (const f32x2*)(ws + WS_TAB64);
    const float* gq = p->in[22] + l * 256; const float* gkv = p->in[24] + l * 128;
    for (int row = gw; row < NTOK + 1024; row += NGW) {
        if (row >= NTOK) {
            const int cr = row - NTOK, b = cr >> 8, j = cr & 255; const size_t kv = (size_t)8192 + b * 4352 + j; const size_t ci = (size_t)(b * 2 + l) * 256 + j;
#pragma unroll
            for (int i = 0; i < 4; ++i) { const int c = 64 * i + lane; Ka[kv * 256 + c] = f2bf(p->in[2][ci * 256 + c]); Va[kv * 256 + c] = f2bf(p->in[3][ci * 256 + c]); }
#pragma unroll
            for (int i = 0; i < 2; ++i) { const int c = 64 * i + lane; Kb[kv * 128 + c] = f2bf(p->in[4][ci * 128 + c]); Vb[kv * 128 + c] = f2bf(p->in[5][ci * 128 + c]); Kc[kv * 160 + c] = f2bf(p->in[6][ci * 128 + c]); }
            if (lane < 32) Kc[kv * 160 + 128 + rope_perm32(lane)] = f2bf(p->in[7][ci * 32 + lane]);
            continue;
        }
        const bool lat = row >= NPTOK;
        const int t = (row - NPTOK) & 4095, prow = t >> 6, pcol = t & 63, bidx = (row - NPTOK) >> 12;
        const size_t kv = lat ? (size_t)8192 + bidx * 4352 + 256 + t : (size_t)row;
        const size_t orow = lat ? 0 : (size_t)((row >> 8) * 2 + l) * 256 + (row & 255);
        const bf16_t* pr = proj + (size_t)row * INWP;
        float* out = p->out;
        {
            const int c = lane & 31, src = 8 * lane, dch = c & 3; float v[8]; pp_unpack8(*(const u32x4*)(pr + src), v);
            if (lat) { float pv[8]; pp_unpack8(*(const u32x4*)(pr + (src ^ 8)), pv); pp_rope8(v, pv, dch & 1, tab32 + ((dch < 2) ? prow : pcol) * 8); }
            if (lane < 32) { *(u32x4*)(Qa + (size_t)row * 256 + 8 * c) = pp_pack8(v, QSC_A); }
            else { *(u32x4*)(Ka + kv * 256 + 8 * c) = pp_pack8(v, 1.0f); if (!lat) pp_store8f(out + OUT_AK + orow * 256 + 8 * c, v); }
        }
        {
            if (lane < 32) { const int c = lane; float v[8]; pp_unpack8(*(const u32x4*)(pr + 512 + 8 * c), v);
                *(u32x4*)(Va + kv * 256 + 8 * c) = pp_pack8(v, 1.0f); if (!lat) pp_store8f(out + OUT_AV + orow * 256 + 8 * c, v); }
            else { const int c = lane - 32, src = 768 + 8 * c, dch = c & 7; float v[8]; pp_unpack8(*(const u32x4*)(pr + src), v);
                if (lat) { float pv[8]; pp_unpack8(*(const u32x4*)(pr + (src ^ 16)), pv); pp_rope8(v, pv, (dch >> 1) & 1, tab64 + ((dch < 4) ? prow : pcol) * 16 + 8 * (dch & 1)); }
                *(u32x4*)(Qb + (size_t)row * 512 + 8 * c) = pp_pack8(v, QSC_B); }
        }
        {
            if (lane < 48) { const bool isq = lane < 32; const int c = isq ? 32 + lane : lane - 32, src = (isq ? 768 : 1280) + 8 * c, dch = c & 7; float v[8]; pp_unpack8(*(const u32x4*)(pr + src), v);
                if (lat) { float pv[8]; pp_unpack8(*(const u32x4*)(pr + (src ^ 16)), pv); pp_rope8(v, pv, (dch >> 1) & 1, tab64 + ((dch < 4) ? prow : pcol) * 16 + 8 * (dch & 1)); }
                if (isq) *(u32x4*)(Qb + (size_t)row * 512 + 8 * c) = pp_pack8(v, QSC_B);
                else { *(u32x4*)(Kb + kv * 128 + 8 * c) = pp_pack8(v, 1.0f); if (!lat) pp_store8f(out + OUT_BK + orow * 128 + 8 * c, v); } }
            else { const int c = lane - 48; float v[8]; pp_unpack8(*(const u32x4*)(pr + 1408 + 8 * c), v);
                *(u32x4*)(Vb + kv * 128 + 8 * c) = pp_pack8(v, 1.0f); if (!lat) pp_store8f(out + OUT_BV + orow * 128 + 8 * c, v); }
        }
        {
            const int c = lane < 32 ? lane : (lane < 48 ? lane - 32 : lane - 48);
            const int src = (lane < 32 ? 1536 : (lane < 48 ? 1792 : 1920)) + 8 * c;
            float v[8];
            if (lane < 52) pp_unpack8(*(const u32x4*)(pr + src), v); else {
#pragma unroll
                for (int e = 0; e < 8; ++e) v[e] = 0.f; }
            float ss = 0.f;
#pragma unroll
            for (int e = 0; e < 8; ++e) ss += v[e] * v[e];
            const float ssq = wave_sum(lane < 32 ? ss : 0.f), sskv = wave_sum((lane >= 32 && lane < 48) ? ss : 0.f);
            if (lane < 32) { const float rstd = 1.f / sqrtf(ssq * (1.f / 256.f) + 1e-6f); const f32x4 g0 = *(const f32x4*)(gq + 8 * c), g1 = *(const f32x4*)(gq + 8 * c + 4);
                v[0] *= rstd * g0[0]; v[1] *= rstd * g0[1]; v[2] *= rstd * g0[2]; v[3] *= rstd * g0[3]; v[4] *= rstd * g1[0]; v[5] *= rstd * g1[1]; v[6] *= rstd * g1[2]; v[7] *= rstd * g1[3];
                *(u32x4*)(cqn + (size_t)row * 256 + 8 * c) = pp_pack8(v, 1.0f); }
            else if (lane < 48) { const float rstd = 1.f / sqrtf(sskv * (1.f / 128.f) + 1e-6f); const f32x4 g0 = *(const f32x4*)(gkv + 8 * c), g1 = *(const f32x4*)(gkv + 8 * c + 4);
                v[0] *= rstd * g0[0]; v[1] *= rstd * g0[1]; v[2] *= rstd * g0[2]; v[3] *= rstd * g0[3]; v[4] *= rstd * g1[0]; v[5] *= rstd * g1[1]; v[6] *= rstd * g1[2]; v[7] *= rstd * g1[3];
                *(u32x4*)(Kc + kv * 160 + 8 * c) = pp_pack8(v, 1.0f); if (!lat) pp_store8f(out + OUT_CKV + orow * 128 + 8 * c, v); }
            else if (lane < 52) {
                if (!lat) pp_store8f(out + OUT_CKPE + orow * 32 + 8 * c, v);
                if (lat) { float pv[8]; pp_unpack8(*(const u32x4*)(pr + (src ^ 8)), pv); pp_rope8(v, pv, c & 1, tab32 + ((c < 2) ? prow : pcol) * 8); }
#pragma unroll
                for (int e = 0; e < 8; ++e) Kc[kv * 160 + 128 + rope_perm32(8 * c + e)] = f2bf(v[e]); }
        }
    }
}

__device__ __forceinline__ float a_max3(float a, float b, float c) { float r; asm("v_max3_f32 %0, %1, %2, %3" : "=v"(r) : "v"(a), "v"(b), "v"(c)); return r; }
__device__ __forceinline__ float a_max2(float a, float b) { float r; asm("v_max_f32_e32 %0, %1, %2" : "=v"(r) : "v"(a), "v"(b)); return r; }
template <int GRP> struct ACfg;
template <> struct ACfg<0> { static constexpr int NSUB = 2, KS = 2, DK = 64, DV = 64; };
template <> struct ACfg<1> { static constexpr int NSUB = 1, KS = 4, DK = 64, DV = 64; };
template <> struct ACfg<2> { static constexpr int NSUB = 1, KS = 10, DK = 160, DV = 128; };
__device__ __forceinline__ int crow(int r, int hi) { return (r & 3) + 8 * (r >> 2) + 4 * hi; }

template <int GRP>
__device__ __forceinline__ void attn_item(KPtr p, int l, bool lat, int req, int hsel, int q0, LAS unsigned char* lds) {
    constexpr int NSUB = ACfg<GRP>::NSUB, KS = ACfg<GRP>::KS, DK = ACfg<GRP>::DK, DV = ACfg<GRP>::DV, DVB = DV / 32;
    constexpr int KSTR = (DK + 8) * 2, VSTR = (GRP == 2) ? KSTR : 144, KIMG = 64 * KSTR, VIMG = (GRP == 2) ? 0 : 64 * VSTR, BUF = KIMG + VIMG;
    constexpr int KCH = DK / 8, NKC = 64 * KCH, NSLOT = (NKC + 511) / 512, VIMG_OFF = (GRP == 2) ? 0 : KIMG;
    const int tid = TID(), lane = tid & 63, wid = tid >> 6, r32 = lane & 31, hi = lane >> 5;
    unsigned char* ws = p->ws;
    const int tok0 = lat ? 8192 + req * 4096 : req * 256;
    const int kv0 = lat ? 8192 + req * 4352 : req * 256;
    int n1, nt, rbase1, rbase2;
    if (GRP == 1 && lat) { const int lo = q0 < 128 ? (128 - q0) / 64 : 0; int hiT = (4224 - q0) / 64 - 1; hiT = hiT > 4 ? 4 : hiT;
        n1 = 4; nt = 4 + hiT - lo + 1; rbase1 = kv0; rbase2 = kv0 + 256 + q0 - 128 + 64 * lo; }
    else { n1 = nt = lat ? 68 : 4; rbase1 = kv0; rbase2 = 0; }
    const bf16_t* Kg; const bf16_t* Vg; int kstride, qrow; const bf16_t* Qp;
    if (GRP == 0) { Kg = (const bf16_t*)(ws + WS_KA) + 64 * hsel; Vg = (const bf16_t*)(ws + WS_VA) + 64 * hsel; kstride = 256;
        qrow = tok0 + q0 + 32 * wid + r32; Qp = (const bf16_t*)(ws + WS_QA) + (size_t)qrow * 256 + 64 * hsel + 8 * hi; }
    else if (GRP == 1) { Kg = (const bf16_t*)(ws + WS_KB) + 64 * hsel; Vg = (const bf16_t*)(ws + WS_VB) + 64 * hsel; kstride = 128;
        qrow = tok0 + q0 + 32 * (wid & 1) + r32; Qp = (const bf16_t*)(ws + WS_QB) + (size_t)qrow * 512 + (4 * hsel + (wid >> 1)) * 64 + 8 * hi; }
    else { Kg = (const bf16_t*)(ws + WS_KC); Vg = Kg; kstride = 160;
        qrow = tok0 + q0 + 32 * (wid & 1) + r32; Qp = (const bf16_t*)(ws + WS_QC) + (size_t)qrow * 768 + 8 * hi; }
    bf16x8 qf[NSUB][KS];
#pragma unroll
    for (int s = 0; s < NSUB; ++s)
#pragma unroll
        for (int ks = 0; ks < KS; ++ks) {
            int off;
            if (GRP == 0) off = 32 * s + 16 * ks; else if (GRP == 1) off = 16 * ks; else off = (ks < 8) ? 128 * (wid >> 1) + 16 * ks : 512 + 32 * (wid >> 1) + 16 * (ks - 8);
            qf[s][ks] = __builtin_nontemporal_load((const bf16x8*)(Qp + off));
        }
    if (GRP == 2 && lat) {
        const int qp_ = q0 + 32 * (wid & 1) + r32; const f32x2* tab32 = (const f32x2*)(ws + WS_TAB32);
#pragma unroll
        for (int ks = 8; ks < 10; ++ks) { const int pos = (ks == 8) ? (qp_ >> 6) : (qp_ & 63); u32x4 w = __builtin_bit_cast(u32x4, qf[0][ks < KS ? ks : 0]); u32x4 o;
#pragma unroll
            for (int j = 0; j < 4; ++j) { const f32x2 cs = tab32[pos * 8 + 4 * hi + j]; const unsigned wj = (j == 0) ? w.x : (j == 1) ? w.y : (j == 2) ? w.z : w.w;
                const float x1 = __uint_as_float(wj << 16), x2 = __uint_as_float(wj & 0xffff0000u);
                const unsigned r = pg8::cvt_pk_bf16(x1 * cs.x - x2 * cs.y, x2 * cs.x + x1 * cs.y);
                if (j == 0) o.x = r; else if (j == 1) o.y = r; else if (j == 2) o.z = r; else o.w = r; }
            qf[0][ks < KS ? ks : 0] = __builtin_bit_cast(bf16x8, o); }
    }
    float m_run[NSUB], l_run[NSUB]; f32x16 O[NSUB][DVB];
#pragma unroll
    for (int s = 0; s < NSUB; ++s) { m_run[s] = 0.f; l_run[s] = 0.f;
#pragma unroll
        for (int d = 0; d < DVB; ++d)
#pragma unroll
            for (int r = 0; r < 16; ++r) O[s][d][r] = 0.f; }
    if (GRP == 1) { const float sk = p->in[21][l * 8 + 4 * hsel + (wid >> 1)] * LOG2E; m_run[0] = sk; l_run[0] = hi == 0 ? 1.f : 0.f; }
    const int qpos = q0 + 32 * (wid & 1) + r32;
    u32x4 kreg[NSLOT]; u32x4 vreg;
    int krow[NSLOT], kcc[NSLOT];
#pragma unroll
    for (int s = 0; s < NSLOT; ++s) { const int ci = tid + 512 * s; krow[s] = ci / KCH; kcc[s] = ci % KCH; }
#define A_TROW(i) ((i) < n1 ? rbase1 + 64 * (i) : rbase2 + 64 * ((i) - n1))
#define A_LOAD(i) do { const size_t tr_ = (size_t)A_TROW(i); \
        _Pragma("unroll") for (int s = 0; s < NSLOT; ++s) if (NKC % 512 == 0 || s < NSLOT - 1 || tid + 512 * s < NKC) kreg[s] = *(const u32x4*)(Kg + (tr_ + krow[s]) * kstride + 8 * kcc[s]); \
        if (GRP != 2) vreg = *(const u32x4*)(Vg + (tr_ + krow[0]) * kstride + 8 * kcc[0]); } while (0)
#define A_STORE(boff) do { LAS unsigned char* b_ = lds + (boff); \
        _Pragma("unroll") for (int s = 0; s < NSLOT; ++s) if (NKC % 512 == 0 || s < NSLOT - 1 || tid + 512 * s < NKC) \
            *(LAS u32x4*)(b_ + krow[s] * KSTR + kcc[s] * 16) = kreg[s]; \
        if (GRP != 2) *(LAS u32x4*)(b_ + KIMG + krow[0] * VSTR + kcc[0] * 16) = vreg; } while (0)

    f32x16 sc0[NSUB], sc1[NSUB]; bf16x8 pf[NSUB][4];
    constexpr bool NEGM = (GRP == 1);
    f32x16 negm[NSUB];
#pragma unroll
    for (int s = 0; s < NSUB; ++s) {
#pragma unroll
        for (int r = 0; r < 16; ++r) negm[s][r] = -m_run[s];
        if (NEGM) asm volatile("" : "+v"(negm[s])); }
#define A_KRD(ks_, blk_) (*(const LAS bf16x8*)(kb_ + ((blk_) * 32 + r32) * KSTR + ((s * KS + (ks_)) * 16 + 8 * hi) * 2))
#define DO_QK_S(i_, s) do { const LAS unsigned char* kb_ = lds + bo_cur; \
        { \
            if (!NEGM) { const float nm_ = -m_run[s]; _Pragma("unroll") for (int r = 0; r < 16; ++r) { sc0[s][r] = nm_; sc1[s][r] = nm_; } } \
            constexpr int KD = (GRP == 2) ? 1 : 2;        \
            bf16x8 kq[KD + 1][2]; \
            kq[0][0] = A_KRD(0, 0); kq[0][1] = A_KRD(0, 1); \
            if (KS > 1 && KD > 1) { kq[1][0] = A_KRD(1, 0); kq[1][1] = A_KRD(1, 1); } \
            _Pragma("unroll") for (int ks = 0; ks < KS; ++ks) { \
                if (ks + KD < KS) { kq[(ks + KD) % (KD + 1)][0] = A_KRD(ks + KD, 0); kq[(ks + KD) % (KD + 1)][1] = A_KRD(ks + KD, 1); } \
                __builtin_amdgcn_sched_barrier(0); \
                sc0[s] = __builtin_amdgcn_mfma_f32_32x32x16_bf16(kq[ks % (KD + 1)][0], qf[s][ks], (NEGM && ks == 0) ? negm[s] : sc0[s], 0, 0, 0); \
                sc1[s] = __builtin_amdgcn_mfma_f32_32x32x16_bf16(kq[ks % (KD + 1)][1], qf[s][ks], (NEGM && ks == 0) ? negm[s] : sc1[s], 0, 0, 0); \
                __builtin_amdgcn_sched_barrier(0); } } } while (0)
#define DO_SM_S(i_, s) do { const bool local_tile = (GRP == 1) && lat && ((i_) >= n1); const int kpos0 = local_tile ? (A_TROW(i_) - (kv0 + 256)) : 0; const bool first_ = (GRP != 1) && ((i_) == 0); \
        { \
            if (local_tile) { _Pragma("unroll") for (int r = 0; r < 16; ++r) { const int d0 = kpos0 + crow(r, hi) - qpos; const int d1 = d0 + 32; \
                if (d0 > 128 || d0 < -128) sc0[s][r] = -1e30f; if (d1 > 128 || d1 < -128) sc1[s][r] = -1e30f; } } \
            asm volatile("s_nop 15\n\ts_nop 7" : "+v"(sc0[s]), "+v"(sc1[s]));        \
            float mx = a_max3(sc0[s][0], sc1[s][0], sc0[s][1]), mxb = a_max3(sc1[s][1], sc0[s][2], sc1[s][2]); \
            _Pragma("unroll") for (int r = 3; r < 15; r += 2) { mx = a_max3(mx, sc0[s][r], sc1[s][r]); mxb = a_max3(mxb, sc0[s][r + 1], sc1[s][r + 1]); } \
            mx = a_max3(mx, sc0[s][15], sc1[s][15]); mx = a_max2(mx, mxb); \
            mx = a_max2(mx, __shfl_xor(mx, 32)); \
            if (first_) { m_run[s] = mx; _Pragma("unroll") for (int r = 0; r < 16; ++r) { sc0[s][r] -= mx; sc1[s][r] -= mx; } \
                if (NEGM) { _Pragma("unroll") for (int r = 0; r < 16; ++r) negm[s][r] = -mx; asm volatile("" : "+v"(negm[s])); } } \
            else if (__any(mx > 6.0f)) {          \
                const float dl = fmaxf(mx, 0.f); const float alpha = __builtin_amdgcn_exp2f(-dl); \
                l_run[s] *= alpha; m_run[s] += dl; \
                if (NEGM) { _Pragma("unroll") for (int r = 0; r < 16; ++r) negm[s][r] = -m_run[s]; asm volatile("" : "+v"(negm[s])); } \
                _Pragma("unroll") for (int d = 0; d < DVB; ++d) _Pragma("unroll") for (int r = 0; r < 16; ++r) O[s][d][r] *= alpha; \
                _Pragma("unroll") for (int r = 0; r < 16; ++r) { sc0[s][r] -= dl; sc1[s][r] -= dl; } } \
            float rs = 0.f; \
            _Pragma("unroll") for (int r = 0; r < 16; ++r) { sc0[s][r] = __builtin_amdgcn_exp2f(sc0[s][r]); sc1[s][r] = __builtin_amdgcn_exp2f(sc1[s][r]); rs += sc0[s][r] + sc1[s][r]; } \
            l_run[s] += rs; \
            _Pragma("unroll") for (int kk = 0; kk < 4; ++kk) { u32x4 w; \
                if (kk < 2) { const int b = 8 * kk; w.x = pg8::cvt_pk_bf16(sc0[s][b], sc0[s][b + 1]); w.y = pg8::cvt_pk_bf16(sc0[s][b + 2], sc0[s][b + 3]); w.z = pg8::cvt_pk_bf16(sc0[s][b + 4], sc0[s][b + 5]); w.w = pg8::cvt_pk_bf16(sc0[s][b + 6], sc0[s][b + 7]); } \
                else { const int b = 8 * (kk - 2); w.x = pg8::cvt_pk_bf16(sc1[s][b], sc1[s][b + 1]); w.y = pg8::cvt_pk_bf16(sc1[s][b + 2], sc1[s][b + 3]); w.z = pg8::cvt_pk_bf16(sc1[s][b + 4], sc1[s][b + 5]); w.w = pg8::cvt_pk_bf16(sc1[s][b + 6], sc1[s][b + 7]); } \
                pf[s][kk] = __builtin_bit_cast(bf16x8, w); } } } while (0)
#define A_VRD(dst, n_) do { const int d_ = (n_) % DVB, kk_ = (n_) / DVB; const LAS unsigned char* vp = vb_ + (32 * (kk_ >> 1) + 16 * (kk_ & 1)) * VSTR + 64 * d_; \
        const s16x4 lo = __builtin_bit_cast(s16x4, __builtin_amdgcn_ds_read_tr16_b64_v4i16((LAS v4i16_t*)vp)); \
        const s16x4 hi2 = __builtin_bit_cast(s16x4, __builtin_amdgcn_ds_read_tr16_b64_v4i16((LAS v4i16_t*)(vp + 8 * VSTR))); \
        dst = (bf16x8){lo[0], lo[1], lo[2], lo[3], hi2[0], hi2[1], hi2[2], hi2[3]}; } while (0)
#define DO_PV(i_) do { const LAS unsigned char* vb_ = lds + bo_cur + VIMG_OFF + (4 * hi + ((lane & 15) >> 2)) * VSTR + (16 * ((lane >> 4) & 1) + 4 * (lane & 3)) * 2; \
        constexpr int NPV = 4 * DVB; \
        _Pragma("unroll") for (int s = 0; s < NSUB; ++s) { \
            bf16x8 vq[3]; A_VRD(vq[0], 0); A_VRD(vq[1], 1); \
            _Pragma("unroll") for (int n = 0; n < NPV; ++n) { \
                if (n + 2 < NPV) A_VRD(vq[(n + 2) % 3], n + 2); \
                __builtin_amdgcn_sched_barrier(0); \
                O[s][n % DVB] = __builtin_amdgcn_mfma_f32_32x32x16_bf16(vq[n % 3], pf[s][n / DVB], O[s][n % DVB], 0, 0, 0); \
                __builtin_amdgcn_sched_barrier(0); } } } while (0)

#define A_EXPPACK_PLAIN(s) do { float rs = 0.f; \
        _Pragma("unroll") for (int r = 0; r < 16; ++r) { sc0[s][r] = __builtin_amdgcn_exp2f(sc0[s][r]); sc1[s][r] = __builtin_amdgcn_exp2f(sc1[s][r]); rs += sc0[s][r] + sc1[s][r]; } \
        l_run[s] += rs; \
        _Pragma("unroll") for (int kk = 0; kk < 4; ++kk) { u32x4 w; \
            if (kk < 2) { const int b = 8 * kk; w.x = pg8::cvt_pk_bf16(sc0[s][b], sc0[s][b + 1]); w.y = pg8::cvt_pk_bf16(sc0[s][b + 2], sc0[s][b + 3]); w.z = pg8::cvt_pk_bf16(sc0[s][b + 4], sc0[s][b + 5]); w.w = pg8::cvt_pk_bf16(sc0[s][b + 6], sc0[s][b + 7]); } \
            else { const int b = 8 * (kk - 2); w.x = pg8::cvt_pk_bf16(sc1[s][b], sc1[s][b + 1]); w.y = pg8::cvt_pk_bf16(sc1[s][b + 2], sc1[s][b + 3]); w.z = pg8::cvt_pk_bf16(sc1[s][b + 4], sc1[s][b + 5]); w.w = pg8::cvt_pk_bf16(sc1[s][b + 6], sc1[s][b + 7]); } \
            pf[s][kk] = __builtin_bit_cast(bf16x8, w); } } while (0)
#define A_PV_PLAIN(s) do { constexpr int NPV = 4 * DVB; bf16x8 vq[3]; A_VRD(vq[0], 0); A_VRD(vq[1], 1); \
        _Pragma("unroll") for (int n = 0; n < NPV; ++n) { \
            if (n + 2 < NPV) A_VRD(vq[(n + 2) % 3], n + 2); \
            __builtin_amdgcn_sched_barrier(0); \
            O[s][n % DVB] = __builtin_amdgcn_mfma_f32_32x32x16_bf16(vq[n % 3], pf[s][n / DVB], O[s][n % DVB], 0, 0, 0); \
            __builtin_amdgcn_sched_barrier(0); } } while (0)
#define A_SCE(s, e) ((e) < 16 ? sc0[s][(e) & 15] : sc1[s][(e) & 15])
#define DO_SMPV_S(i_, s) do { const bool local_tile = (GRP == 1) && lat && ((i_) >= n1); const int kpos0 = local_tile ? (A_TROW(i_) - (kv0 + 256)) : 0; \
        const LAS unsigned char* vb_ = lds + bo_prev + VIMG_OFF + (4 * hi + ((lane & 15) >> 2)) * VSTR + (16 * ((lane >> 4) & 1) + 4 * (lane & 3)) * 2; \
        { \
            if (local_tile) { _Pragma("unroll") for (int r = 0; r < 16; ++r) { const int d0 = kpos0 + crow(r, hi) - qpos; const int d1 = d0 + 32; \
                if (d0 > 128 || d0 < -128) sc0[s][r] = -1e30f; if (d1 > 128 || d1 < -128) sc1[s][r] = -1e30f; } } \
            asm volatile("s_nop 15\n\ts_nop 7" : "+v"(sc0[s]), "+v"(sc1[s]));        \
            float mx = a_max3(sc0[s][0], sc1[s][0], sc0[s][1]), mxb = a_max3(sc1[s][1], sc0[s][2], sc1[s][2]); \
            _Pragma("unroll") for (int r = 3; r < 15; r += 2) { mx = a_max3(mx, sc0[s][r], sc1[s][r]); mxb = a_max3(mxb, sc0[s][r + 1], sc1[s][r + 1]); } \
            mx = a_max3(mx, sc0[s][15], sc1[s][15]); mx = a_max2(mx, mxb); \
            mx = a_max2(mx, __shfl_xor(mx, 32)); \
            if (__any(mx > 6.0f)) {          \
                const float dl = fmaxf(mx, 0.f); const float alpha = __builtin_amdgcn_exp2f(-dl); \
                l_run[s] *= alpha; m_run[s] += dl; \
                if (NEGM) { _Pragma("unroll") for (int r = 0; r < 16; ++r) negm[s][r] = -m_run[s]; asm volatile("" : "+v"(negm[s])); } \
                _Pragma("unroll") for (int d = 0; d < DVB; ++d) _Pragma("unroll") for (int r = 0; r < 16; ++r) O[s][d][r] *= alpha; \
                _Pragma("unroll") for (int r = 0; r < 16; ++r) { sc0[s][r] -= dl; sc1[s][r] -= dl; } \
                _Pragma("unroll") for (int kk = 0; kk < 4; ++kk) { u32x4 w = __builtin_bit_cast(u32x4, pf[s][kk]); \
                    w.x = pg8::cvt_pk_bf16(__uint_as_float(w.x << 16) * alpha, __uint_as_float(w.x & 0xffff0000u) * alpha); w.y = pg8::cvt_pk_bf16(__uint_as_float(w.y << 16) * alpha, __uint_as_float(w.y & 0xffff0000u) * alpha); \
                    w.z = pg8::cvt_pk_bf16(__uint_as_float(w.z << 16) * alpha, __uint_as_float(w.z & 0xffff0000u) * alpha); w.w = pg8::cvt_pk_bf16(__uint_as_float(w.w << 16) * alpha, __uint_as_float(w.w & 0xffff0000u) * alpha); \
                    pf[s][kk] = __builtin_bit_cast(bf16x8, w); } \
            } \
            { \
                constexpr int NPV = 4 * DVB, EPM = 32 / NPV; \
                bf16x8 vq[3]; A_VRD(vq[0], 0); A_VRD(vq[1], 1); float rs = 0.f; \
                _Pragma("unroll") for (int n = 0; n < NPV; ++n) { \
                    if (n + 2 < NPV) A_VRD(vq[(n + 2) % 3], n + 2); \
                    __builtin_amdgcn_sched_barrier(0); \
                    O[s][n % DVB] = __builtin_amdgcn_mfma_f32_32x32x16_bf16(vq[n % 3], pf[s][n / DVB], O[s][n % DVB], 0, 0, 0); \
                    _Pragma("unroll") for (int e = n * EPM; e < (n + 1) * EPM; ++e) { const float x_ = __builtin_amdgcn_exp2f(A_SCE(s, e)); if (e < 16) sc0[s][e & 15] = x_; else sc1[s][e & 15] = x_; rs += x_; } \
                    if ((n + 1) % DVB == 0) { const int kk = n / DVB; const int b = 8 * (kk & 1); u32x4 w; \
                        if (kk < 2) { w.x = pg8::cvt_pk_bf16(sc0[s][b], sc0[s][b + 1]); w.y = pg8::cvt_pk_bf16(sc0[s][b + 2], sc0[s][b + 3]); w.z = pg8::cvt_pk_bf16(sc0[s][b + 4], sc0[s][b + 5]); w.w = pg8::cvt_pk_bf16(sc0[s][b + 6], sc0[s][b + 7]); } \
                        else { w.x = pg8::cvt_pk_bf16(sc1[s][b], sc1[s][b + 1]); w.y = pg8::cvt_pk_bf16(sc1[s][b + 2], sc1[s][b + 3]); w.z = pg8::cvt_pk_bf16(sc1[s][b + 4], sc1[s][b + 5]); w.w = pg8::cvt_pk_bf16(sc1[s][b + 6], sc1[s][b + 7]); } \
                        pf[s][kk] = __builtin_bit_cast(bf16x8, w); } \
                    __builtin_amdgcn_sched_barrier(0); } \
                l_run[s] += rs; \
            } } } while (0)

    int bo_prev = 2 * BUF, bo_cur = 0, bo_next = BUF;
    A_LOAD(0); A_STORE(0); if (nt > 1) A_LOAD(1);
    __syncthreads();
    if (nt > 1) { A_STORE(bo_next); if (nt > 2) A_LOAD(2); }
#pragma unroll
    for (int s = 0; s < NSUB; ++s) { DO_QK_S(0, s); DO_SM_S(0, s); }
    __syncthreads();
    for (int i = 1; i < nt; ++i) {
        { const int t_ = bo_prev; bo_prev = bo_cur; bo_cur = bo_next; bo_next = t_; }
        if (i + 1 < nt) { A_STORE(bo_next); if (i + 2 < nt) A_LOAD(i + 2); }
#pragma unroll
        for (int s = 0; s < NSUB; ++s) { DO_QK_S(i, s); DO_SMPV_S(i, s); }
        __syncthreads();
    }
    DO_PV(nt - 1);
    __syncthreads();
#undef A_KRD
#undef A_VRD
#undef DO_QK_S
#undef DO_SM_S
#undef DO_PV
#undef DO_SMPV_S
#undef A_EXPPACK_PLAIN
#undef A_PV_PLAIN
#undef A_SCE
#undef A_TROW
#undef A_LOAD
#undef A_STORE
    constexpr int SROW = (DV == 128) ? 256 : 144;
    static_assert(3 * BUF <= 65536 && 65536 + 8 * 32 * SROW <= 131072, "attention LDS map");
    LAS unsigned char* stg = lds + 65536 + wid * (32 * SROW);
    bf16_t* obase = (bf16_t*)(ws + WS_OMIX) + (size_t)(qrow - r32) * MIXK;
#define A_OUT(cb_) do { asm volatile("s_waitcnt lgkmcnt(0)" ::: "memory"); \
        _Pragma("unroll") for (int it_ = 0; it_ < DV / 16; ++it_) { const int idx_ = it_ * 64 + lane, row_ = idx_ / (DV / 8), ch_ = idx_ % (DV / 8); \
            const u32x4 v_ = *(const LAS u32x4*)(stg + row_ * SROW + ch_ * 16); *(u32x4*)(obase + (size_t)row_ * MIXK + (cb_) + 8 * ch_) = v_; } } while (0)
    if (GRP == 0) {
        const float* lp = p->in[19] + l * 128;
        float d01 = 0.f, d23 = 0.f;
#pragma unroll 8
        for (int i = 0; i < 32; ++i) { d01 += lp[i] * lp[32 + i]; d23 += lp[64 + i] * lp[96 + i]; }
        const float lam_init = l == 0 ? 0.2f : 0.35550906759096924f;
        const float lam = __expf(d01) - __expf(d23) + lam_init;
        const float i1 = 1.f / (l_run[0] + __shfl_xor(l_run[0], 32)), i2 = lam / (l_run[1] + __shfl_xor(l_run[1], 32));
        float ss = 0.f;
#pragma unroll
        for (int d = 0; d < DVB; ++d)
#pragma unroll
            for (int r = 0; r < 16; ++r) { const float v = O[0][d][r] * i1 - O[1][d][r] * i2; O[0][d][r] = v; ss += v * v; }
        ss += __shfl_xor(ss, 32);
        const float rstd = (1.f - lam_init) / sqrtf(ss * (1.f / 64.f) + 1e-6f);
        const float* sg = p->in[20] + l * 64;
#pragma unroll
        for (int d = 0; d < DVB; ++d)
#pragma unroll
            for (int g = 0; g < 4; ++g) { const int dv = 32 * d + 8 * g + 4 * hi; const f32x4 gg = *(const f32x4*)(sg + dv);
                u32x2 w; w.x = pg8::cvt_pk_bf16(O[0][d][4 * g] * rstd * gg[0], O[0][d][4 * g + 1] * rstd * gg[1]); w.y = pg8::cvt_pk_bf16(O[0][d][4 * g + 2] * rstd * gg[2], O[0][d][4 * g + 3] * rstd * gg[3]);
                *(LAS u32x2*)(stg + r32 * SROW + dv * 2) = w; }
        A_OUT(64 * hsel);
    } else {
        const float inv = 1.f / (l_run[0] + __shfl_xor(l_run[0], 32));
        const int cbase = (GRP == 1) ? 256 + (4 * hsel + (wid >> 1)) * 64 : 768 + 128 * (wid >> 1);
#pragma unroll
        for (int d = 0; d < DVB; ++d)
#pragma unroll
            for (int g = 0; g < 4; ++g) { const int dv = 32 * d + 8 * g + 4 * hi;
                u32x2 w; w.x = pg8::cvt_pk_bf16(O[0][d][4 * g] * inv, O[0][d][4 * g + 1] * inv); w.y = pg8::cvt_pk_bf16(O[0][d][4 * g + 2] * inv, O[0][d][4 * g + 3] * inv);
                *(LAS u32x2*)(stg + r32 * SROW + dv * 2) = w; }
        A_OUT(cbase);
    }
#undef A_OUT
}

__device__ __forceinline__ void phase_attn(KPtr p, int l, LAS unsigned char* lds, int it_lo, int it_hi) {
    const int nblk = NBLK(), bid = BID();
    const int vcu = (nblk % 8 == 0) ? (bid % 8) * (nblk / 8) + bid / 8 : bid;
    for (int it = vcu; it < 1536; it += nblk) {
        if (it < it_lo || it >= it_hi) continue;
        if (it < 256) attn_item<2>(p, l, true, it >> 6, 0, 64 * (it & 63), lds);
        else if (it < 512) { const int i = it - 256; attn_item<0>(p, l, true, i >> 6, (i >> 4) & 3, 256 * (i & 15), lds); }
        else if (it < 1024) { const int i = it - 512; attn_item<1>(p, l, true, i >> 7, (i >> 6) & 1, 64 * (i & 63), lds); }
        else if (it < 1152) { const int i = it - 1024; attn_item<2>(p, l, false, i >> 2, 0, 64 * (i & 3), lds); }
        else if (it < 1280) { const int i = it - 1152; attn_item<0>(p, l, false, i >> 2, i & 3, 0, lds); }
        else { const int i = it - 1280; attn_item<1>(p, l, false, i >> 3, (i >> 2) & 1, 64 * (i & 3), lds); }
    }
}

#define XB_TMO      128
#define XB_XCNT(j)  (256  + 64 * (j))
#define XB_XSUB(j)  (1280 + 64 * (j))
#define XB_XGEN(j)  (2304 + 64 * (j))
#define XB_TOP      3328
#define XB_TOPGEN   3392
#define XCD_BAR_WORDS 3456
#define XB_SPIN_CAP (1u << 18)

__device__ __forceinline__ unsigned xb_ld(unsigned* p)              { return __hip_atomic_load(p, __ATOMIC_RELAXED, __HIP_MEMORY_SCOPE_AGENT); }
__device__ __forceinline__ unsigned xb_add(unsigned* p, unsigned v) { return __hip_atomic_fetch_add(p, v, __ATOMIC_RELAXED, __HIP_MEMORY_SCOPE_AGENT); }
__device__ __forceinline__ unsigned xb_xcc_id() { return (unsigned)__builtin_amdgcn_s_getreg((3 << 11) | 20) & 0xFu; }
#define XB_SPIN(cond, bar) do { unsigned _sp = 0; while (cond) { __builtin_amdgcn_s_sleep(1); \
    if ((++_sp & 255u) == 0u) { if (xb_ld(&(bar)[XB_TMO])) break; if (_sp > XB_SPIN_CAP) { atomicAdd(&(bar)[XB_TMO], 1u); break; } } } } while (0)

struct XcdBarrier {
    unsigned* bar; unsigned x;
    volatile LAS unsigned* st;
};

__device__ __forceinline__ XcdBarrier xcd_barrier_post(unsigned* bar, volatile LAS unsigned* st) {
    XcdBarrier b; b.bar = bar; b.x = xb_xcc_id(); b.st = st;
    if (threadIdx.x == 0) (void)xb_add(&bar[XB_XCNT(b.x)], 1u);
    return b;
}
__device__ __forceinline__ void xcd_barrier_complete(unsigned* bar, unsigned x, unsigned& nloc, unsigned& nx) {
    const unsigned G = gridDim.x * gridDim.y * gridDim.z;
    unsigned sum, cnt, mine, sp = 0u;
    for (;;) {
        sum = 0u; cnt = 0u; mine = 0u;
#pragma unroll
        for (unsigned j = 0; j < 16; ++j) { const unsigned c = xb_ld(&bar[XB_XCNT(j)]); sum += c; cnt += (c > 0u) ? 1u : 0u; mine = (j == x) ? c : mine; }
        if (sum == G) break;
        __builtin_amdgcn_s_sleep(1);
        if ((++sp & 255u) == 0u) { if (xb_ld(&bar[XB_TMO])) break; if (sp > XB_SPIN_CAP) { atomicAdd(&bar[XB_TMO], 1u); break; } }
    }
    nloc = mine > 0u ? mine : 1u; nx = cnt > 0u ? cnt : 1u;
}

__device__ __forceinline__ void xcd_barrier(const XcdBarrier& b) {
    asm volatile("s_waitcnt vmcnt(0)" ::: "memory");
    __syncthreads();
    if (threadIdx.x == 0) {
        unsigned* bar = b.bar;
        __builtin_amdgcn_s_waitcnt(0);
        unsigned nloc = b.st[0], nx = b.st[1];
        if (nloc == 0u) { xcd_barrier_complete(bar, b.x, nloc, nx); b.st[0] = nloc; b.st[1] = nx; }
        const unsigned old = xb_add(&bar[XB_XSUB(b.x)], 1u);
        const unsigned gen = old / nloc;
        if (old + 1u == (gen + 1u) * nloc) {
            __builtin_amdgcn_fence(__ATOMIC_RELEASE, "agent");
            asm volatile("s_waitcnt vmcnt(0)" ::: "memory");
            const unsigned og = xb_add(&bar[XB_TOP], 1u);
            const unsigned tg = og / nx;
            if (og + 1u == (tg + 1u) * nx) xb_add(&bar[XB_TOPGEN], 1u);
            else XB_SPIN(xb_ld(&bar[XB_TOPGEN]) == tg, bar);
            __builtin_amdgcn_fence(__ATOMIC_ACQUIRE, "agent");
            xb_add(&bar[XB_XGEN(b.x)], 1u);
            asm volatile("s_waitcnt vmcnt(0)" ::: "memory");
        } else {
            XB_SPIN(xb_ld(&bar[XB_XGEN(b.x)]) == gen, bar);
            __builtin_amdgcn_fence(__ATOMIC_ACQUIRE, "agent");
            asm volatile("s_waitcnt vmcnt(0)" ::: "memory");
        }
    }
    __syncthreads();
}

constexpr int N_PHASES = 2 + 24;
__global__ void __launch_bounds__(512, 2) trunk_fwd(Params p_unused) {
    KPtr p = (KPtr)__builtin_amdgcn_kernarg_segment_ptr();
    extern __shared__ __attribute__((aligned(16))) unsigned char lds_raw[];
    LAS unsigned char* lds = (LAS unsigned char*)lds_raw;
    cg::grid_group grid = cg::this_grid();
    if (threadIdx.x < 2) ((LAS unsigned*)(lds + 131072))[threadIdx.x] = 0u;
    __syncthreads();
    (void)xcd_barrier_post((unsigned*)(p->ws + WS_BAR), (volatile LAS unsigned*)(lds + 131072));
    const int ph_lo = p->ph_lo, ph_hi = p->ph_hi;
#if defined(PROBE_SYNCS)
    for (int i = 0; i < PROBE_SYNCS; ++i) grid.sync();
#endif
#if defined(PROBE_EXTRA_N)
    for (int ph_ = ph_lo; ph_ < ph_hi + PROBE_EXTRA_N; ++ph_) {
#if defined(PROBE_DUP_AT)
        const int ph = ph_ - (ph_ > PROBE_DUP_AT ? 1 : 0);
#else
        const int ph = ph_ < ph_hi ? ph_ : PROBE_EXTRA_PH;
#endif
#else
    for (int ph = ph_lo; ph < ph_hi; ++ph) {
#endif
#if defined(PROBE_EXTRA_N)
        if (ph_ > ph_lo) {
            if (ph_hi < 0) grid.sync();
#else
        if (ph > ph_lo) {
            if (ph_hi < 0) grid.sync();
#endif
            { XcdBarrier b; b.bar = (unsigned*)(p->ws + WS_BAR); b.x = xb_xcc_id(); b.st = (volatile LAS unsigned*)(lds + 131072); xcd_barrier(b); }
        }
        asm volatile("" : "+s"(p));
        unsigned char* ws = p->ws;
        float* mod = (float*)(ws + WS_MOD);
        #ifndef NO_PREP
        if (ph == 0) { phase_prep(p, lds); continue; }
#endif
        if (ph == 1) { phase_rows<0>(p, nullptr, nullptr, mod, mod + 1024); continue; }
        const int l = (ph - 2) / 12, k = (ph - 2) % 12;
#if defined(PROBE_K0)
        const int nrep = ((k == PROBE_K0 || k == PROBE_K1 || k == PROBE_K2) && !(k == 11 && l == 1)) ? 1 + PROBE_N : 1;
        for (int rep = 0; rep < nrep; ++rep) { if (rep) { XcdBarrier b; b.bar = (unsigned*)(p->ws + WS_BAR); b.x = xb_xcc_id(); b.st = (volatile LAS unsigned*)(lds + 131072); xcd_barrier(b); }
#endif
        const float* modl = mod + (size_t)l * 5 * 9216;
        if (k == 0 || k == 9) {
            const int lh = l * 2 + (k == 9);
            pg8::Gemm g{(const bf16_t*)(ws + WS_H), (const bf16_t*)(ws + WS_W13 + lh * W13_ONE), NTOK, 5632, 1024};
            pg8::StaticOrder S; S.init(NTOK, 5632, NBLK(), BID());
            pg8::EpiSwiGLU E{(bf16_t*)(ws + WS_G), DFF};
#ifndef NO_G1
            pg8::gemm_phase<pg8::EpiSwiGLU, pg8::StaticOrder, true, true>(lds, g, S, E);
#endif
        } else if (k == 1 || k == 10 || k == 7) {
            pg8::Gemm g; pg8::EpiResid E; E.kp = (const __attribute__((address_space(4))) pg8::RParams*)p;
            const int pli = (k == 1) ? (l * 3 - 1) : (k == 7 ? l * 3 : l * 3 + 1);
            E.lnoff = (pli + 1) * 1024;
            const int gbase = (int)(WS_MOD / 4) + l * 5 * 9216;
            if (k == 7) { g = pg8::Gemm{(const bf16_t*)(ws + WS_OMIX), (const bf16_t*)(ws + WS_WO + l * WO_ONE), NTOK, 1024, MIXK}; E.goff = gbase + 5 * 1024; E.wgt = 1.0f; }
            else { const int lh = l * 2 + (k == 10); g = pg8::Gemm{(const bf16_t*)(ws + WS_G), (const bf16_t*)(ws + WS_W2 + lh * W2_ONE), NTOK, 1024, DFF}; E.goff = gbase + (k == 1 ? 2 : 8) * 1024; E.wgt = 0.5f; }
            pg8::StaticOrder S; S.init(NTOK, 1024, NBLK(), BID());
#ifndef NO_G2
            pg8::gemm_phase<pg8::EpiResid, pg8::StaticOrder, true, true>(lds, g, S, E);
#endif
        } else if (k == 2 || k == 8 || k == 11) {
            const int li = (k == 2) ? 0 : (k == 8 ? 1 : 2);
            const float* lng = p->in[12] + (size_t)(l * 3 + li) * 1024; const float* lnb = p->in[13] + (size_t)(l * 3 + li) * 1024;
            const bool last = (k == 11 && l == 1);
            const float* mnext = (k == 11 && !last) ? mod + (size_t)(l + 1) * 5 * 9216 : modl;
            const int slot = (k == 2) ? 1 : (k == 8 ? 2 : 0);
            if (last) phase_rows<2>(p, lng, lnb, modl, modl);
            else phase_rows<1>(p, lng, lnb, mnext + (3 * slot) * 1024, mnext + (3 * slot + 1) * 1024);
        } else if (k == 3 || k == 5) {
            pg8::Gemm g; pg8::EpiStoreBf16 E;
            if (k == 3) { g = pg8::Gemm{(const bf16_t*)(ws + WS_H), (const bf16_t*)(ws + WS_WIN + l * WIN_ONE), NTOK, INWP, 1024}; E.O = (bf16_t*)(ws + WS_PROJ); E.ldc = INWP; }
            else { g = pg8::Gemm{(const bf16_t*)(ws + WS_CQN), (const bf16_t*)(ws + WS_WQ + l * WQ_ONE), NTOK, QCW, 256}; E.O = (bf16_t*)(ws + WS_QC); E.ldc = QCW; }
            pg8::StaticOrder S; S.init(NTOK, g.N, NBLK(), BID());
#ifndef NO_G3
            pg8::gemm_phase<pg8::EpiStoreBf16, pg8::StaticOrder, true, true>(lds, g, S, E);
#endif
        } else if (k == 4) {
#ifndef NO_POST
            phase_postproj(p, l);
#endif
        } else {
#ifndef NO_ATTN
#if defined(PROBE_ATT_LO)
            { const bool dup_ = (ph_ == PROBE_DUP_AT + 1); phase_attn(p, l, lds, dup_ ? PROBE_ATT_LO : 0, dup_ ? PROBE_ATT_HI : 1536); }
#else
            phase_attn(p, l, lds, 0, 1536);
#endif
#endif
        }
#if defined(PROBE_K0)
        }
#endif
    }
}

#ifndef MK_PER_PHASE
#define MK_PER_PHASE 0
#endif
extern "C" void kernel_launch(void* const* d_in, const int* in_sizes, int n_in, void* d_out, int out_size, void* d_ws, size_t ws_size, hipStream_t stream) {
    static int grid = 0;
    if (grid == 0) {
        if (n_in != 26 || ws_size < WS_END) { fprintf(stderr, "kernel_launch: need 26 inputs and %zu bytes of workspace (got %d, %zu)\n", (size_t)WS_END, n_in, ws_size); grid = -1; return; }
        int dev = 0, cus = 0, per_cu = 0;
        hipGetDevice(&dev); hipDeviceGetAttribute(&cus, hipDeviceAttributeMultiprocessorCount, dev);
        if (hipFuncSetAttribute((const void*)trunk_fwd, hipFuncAttributeMaxDynamicSharedMemorySize, LDS_BYTES) != hipSuccess) { fprintf(stderr, "kernel_launch: hipFuncSetAttribute failed\n"); grid = -1; return; }
        if (hipOccupancyMaxActiveBlocksPerMultiprocessor(&per_cu, (const void*)trunk_fwd, 512, LDS_BYTES) != hipSuccess || per_cu < 1) { fprintf(stderr, "kernel_launch: occupancy query failed (%d)\n", per_cu); per_cu = 1; }
        (void)hipGetLastError();
        grid = cus * (per_cu > 1 ? 1 : per_cu);
    }
    if (grid < 0) return;
    (void)hipMemsetAsync((char*)d_ws + WS_MOD, 0, ZERO_BYTES, stream);
    Params prm{};
    for (int i = 0; i < 26; ++i) prm.in[i] = (const float*)d_in[i];
    prm.out = (float*)d_out; prm.ws = (unsigned char*)d_ws;
#if MK_PER_PHASE
    for (int ph = 0; ph < N_PHASES; ++ph) { prm.ph_lo = ph; prm.ph_hi = ph + 1; hipLaunchKernelGGL(trunk_fwd, dim3(grid), dim3(512), LDS_BYTES, stream, prm); }
#else
    prm.ph_lo = 0; prm.ph_hi = N_PHASES;
    void* args[] = {&prm};
    hipError_t e = hipLaunchCooperativeKernel((const void*)trunk_fwd, dim3(grid), dim3(512), args, LDS_BYTES, stream);
    if (e != hipSuccess) fprintf(stderr, "cooperative launch failed: %s (grid %d)\n", hipGetErrorString(e), grid);
#endif
}
```
